# Optimizing an MI355X kernel written in HIP

```python
import jax, jax.numpy as jnp
from jax import lax
import numpy as np


D_MODEL = 1024
BATCH = 16
SEQ = 2048
DEPTH = 1

GRID_W = 64
CTX_LEN = 256
HG_DK = 128
HG_HEADS = (D_MODEL // 2) // HG_DK
HG_DV = (D_MODEL // 2) // HG_HEADS
HG_WIDTH = HG_HEADS * HG_DV
RET_HEADS = 4
RET_DK = (D_MODEL // 2) // RET_HEADS
RET_DV = RET_DK
RET_WIDTH = RET_HEADS * RET_DV
MIX_WIDTH = HG_WIDTH + RET_WIDTH
CHUNK = 64
D_FF = ((8 * D_MODEL // 3 + 127) // 128) * 128
CONV_W = 3
ROPE_THETA = 10000.0
EPS = 1e-6
IN_SIZES = (HG_HEADS * HG_DK, HG_WIDTH, HG_HEADS * HG_DK, HG_HEADS * HG_DK, HG_WIDTH,
            RET_HEADS * RET_DK, RET_HEADS * RET_DK, RET_WIDTH, RET_WIDTH)
IN_WIDTH = sum(IN_SIZES)
IN_OFFSETS = tuple(sum(IN_SIZES[:i + 1]) for i in range(len(IN_SIZES) - 1))

kernel_name = 'hymba_hgrn2_retention_convffn_dit_block'


def _rmsnorm(t, g):
    tf = t.astype(jnp.float32)
    y = tf * lax.rsqrt(jnp.mean(tf * tf, axis=-1, keepdims=True) + EPS)
    return (y * g.astype(jnp.float32)).astype(t.dtype)


def _heads(t, n_heads):
    b, L, w = t.shape
    return t.reshape(b, L, n_heads, w // n_heads).transpose(0, 2, 1, 3)


def _merge(t):
    b, h, L, d = t.shape
    return t.transpose(0, 2, 1, 3).reshape(b, L, h * d)


def _flip(t):
    return jnp.flip(t, axis=2)


def _rope_2d(t, rows, cols):
    half = t.shape[-1] // 2
    quarter = half // 2
    freqs = ROPE_THETA ** (-jnp.arange(quarter, dtype=jnp.float32) / quarter)

    def rot(u, pos):
        ang = pos[:, None] * freqs[None, :]
        cos, sin = jnp.cos(ang), jnp.sin(ang)
        u1, u2 = u[..., :quarter], u[..., quarter:]
        return jnp.concatenate([u1 * cos - u2 * sin, u1 * sin + u2 * cos], axis=-1)

    return jnp.concatenate([rot(t[..., :half], rows), rot(t[..., half:], cols)], axis=-1)


def _to_chunks(t):
    b, h, L, d = t.shape
    return jnp.moveaxis(t.reshape(b, h, L // CHUNK, CHUNK, d), 2, 0)


def _from_chunks(t):
    n, b, h, c, d = t.shape
    return jnp.moveaxis(t, 0, 2).reshape(b, h, n * c, d)


def _hgrn2_chunk_scan(q, k, v, logf, s0):
    mask = jnp.tril(jnp.ones((CHUNK, CHUNK), dtype=bool))

    def step(s, inp):
        qc, kc, vc, lfc = inp
        b = jnp.cumsum(lfc, axis=2)
        diff = b[:, :, :, None, :] - b[:, :, None, :, :]
        decay = jnp.where(mask[:, :, None], jnp.exp(jnp.minimum(diff, 0.0)), 0.0)
        attn = jnp.einsum('bhtsk,bhsk->bhts', qc[:, :, :, None, :] * decay, kc)
        o = (jnp.einsum('bhtk,bhkv->bhtv', qc * jnp.exp(b), s)
             + jnp.einsum('bhts,bhsv->bhtv', attn, vc))
        b_last = b[:, :, -1:, :]
        s_new = (jnp.exp(b_last[:, :, 0, :])[..., None] * s
                 + jnp.einsum('bhsk,bhsv->bhkv', kc * jnp.exp(b_last - b), vc))
        return s_new, o

    s_fin, o = lax.scan(step, s0, (_to_chunks(q), _to_chunks(k), _to_chunks(v), _to_chunks(logf)))
    return _from_chunks(o), s_fin


def _hgrn2_final_state(k, v, logf):
    w = jnp.exp(lax.cumsum(logf, axis=2, reverse=True) - logf)
    return jnp.einsum('bhsk,bhsv->bhkv', k * w, v)


def _retention_chunk_scan(q, k, v, log_gamma, r0):
    pos = jnp.arange(CHUNK, dtype=jnp.float32)
    rel = pos[:, None] - pos[None, :]
    lg = log_gamma[:, None, None]
    intra = jnp.where(rel >= 0, jnp.exp(jnp.maximum(rel, 0.0) * lg), 0.0)
    q_dec = jnp.exp((pos + 1.0)[None, :] * log_gamma[:, None])
    k_dec = jnp.exp((CHUNK - 1.0 - pos)[None, :] * log_gamma[:, None])
    chunk_dec = jnp.exp(CHUNK * log_gamma)

    def step(r, inp):
        qc, kc, vc = inp
        scores = jnp.einsum('bhtk,bhsk->bhts', qc, kc) * intra
        o = (jnp.einsum('bhts,bhsv->bhtv', scores, vc)
             + jnp.einsum('bhtk,bhkv->bhtv', qc * q_dec[:, :, None], r))
        r_new = (chunk_dec[:, None, None] * r
                 + jnp.einsum('bhsk,bhsv->bhkv', kc * k_dec[:, :, None], vc))
        return r_new, o

    r_fin, o = lax.scan(step, r0, (_to_chunks(q), _to_chunks(k), _to_chunks(v)))
    return _from_chunks(o), r_fin


def _retention_final_state(k, v, log_gamma):
    L = k.shape[2]
    w = jnp.exp((L - 1.0 - jnp.arange(L, dtype=jnp.float32))[None, :] * log_gamma[:, None])
    return jnp.einsum('bhsk,bhsv->bhkv', k * w[:, :, None], v)


def _mixer_features(h, w_in_l, lb, pos):
    p = (h @ w_in_l).astype(jnp.float32)
    hq, hi, hff, hfb, hg, rq, rk, rv, rg = jnp.split(p, IN_OFFSETS, axis=-1)
    hq = _heads(hq, HG_HEADS)
    hv = _heads(hi, HG_HEADS)
    dirs = []
    for z, lbd in ((hff, lb[0]), (hfb, lb[1])):
        f = lbd + (1.0 - lbd) * jax.nn.sigmoid(_heads(z, HG_HEADS))
        dirs.append((1.0 - f, jnp.log(f)))
    rq = _heads(rq, RET_HEADS)
    rk = _heads(rk, RET_HEADS) * (RET_DK ** -0.5)
    rv = _heads(rv, RET_HEADS)
    if pos is not None:
        rq = _rope_2d(rq, pos[0], pos[1])
        rk = _rope_2d(rk, pos[0], pos[1])
    return (hq, hv, dirs[0], dirs[1], hg, rq, rk, rv, rg)


def _context_states(feats, log_gamma):
    hq, hv, (kf, lff), (kb, lfb), hg, rq, rk, rv, rg = feats
    s_f = _hgrn2_final_state(kf, hv, lff)
    s_b = _hgrn2_final_state(_flip(kb), _flip(hv), _flip(lfb))
    r_f = _retention_final_state(rk, rv, log_gamma[0])
    r_b = _retention_final_state(_flip(rk), _flip(rv), log_gamma[1])
    return (s_f, s_b, r_f, r_b)


def _zero_states(bsz):
    zh = jnp.zeros((bsz, HG_HEADS, HG_DK, HG_DV), jnp.float32)
    zr = jnp.zeros((bsz, RET_HEADS, RET_DK, RET_DV), jnp.float32)
    return (zh, zh, zr, zr)


def _bidir_mix(feats, states, log_gamma, hg_norm_g, ret_norm_g):
    hq, hv, (kf, lff), (kb, lfb), hg, rq, rk, rv, rg = feats
    s_f, s_b, r_f, r_b = states
    o_f, sf_out = _hgrn2_chunk_scan(hq, kf, hv, lff, s_f)
    o_b, sb_out = _hgrn2_chunk_scan(_flip(hq), _flip(kb), _flip(hv), _flip(lfb), s_b)
    hg_o = (o_f + _flip(o_b)) * jax.nn.sigmoid(_heads(hg, HG_HEADS))
    hg_o = _rmsnorm(hg_o, hg_norm_g.reshape(HG_HEADS, 1, HG_DV))
    y_f, rf_out = _retention_chunk_scan(rq, rk, rv, log_gamma[0], r_f)
    y_b, rb_out = _retention_chunk_scan(_flip(rq), _flip(rk), _flip(rv), log_gamma[1], r_b)
    ret_o = _rmsnorm(y_f + _flip(y_b), ret_norm_g.reshape(RET_HEADS, 1, RET_DV))
    ret_o = ret_o * jax.nn.silu(_heads(rg, RET_HEADS))
    mixed = jnp.concatenate([_merge(hg_o), _merge(ret_o)], axis=-1)
    return mixed, (sf_out, sb_out, rf_out, rb_out)


def _conv_ffn(h, w_up_l, conv_w_l, conv_b_l, w_down_l):
    gate, up = jnp.split(h @ w_up_l, 2, axis=-1)
    L = gate.shape[1]
    pad = CONV_W // 2
    gp = jnp.pad(gate, ((0, 0), (pad, pad), (0, 0)))
    gate = sum(gp[:, j:j + L] * conv_w_l[j] for j in range(CONV_W)) + conv_b_l
    return (jax.nn.silu(gate) * up) @ w_down_l


def setup_inputs(seed: int = 0) -> dict:
    key = jax.random.key(seed)
    ks = jax.random.split(key, 19)
    f32 = jnp.float32

    def nrm(k, shape, s):
        return jax.random.normal(k, shape, f32) * s

    x = nrm(ks[0], (BATCH, SEQ, D_MODEL), 1.0)
    c = nrm(ks[1], (BATCH, D_MODEL), 1.0)
    ctx = nrm(ks[2], (BATCH, CTX_LEN, D_MODEL), 1.0)
    c_ctx = nrm(ks[3], (D_MODEL,), 1.0)
    w_mod = nrm(ks[4], (DEPTH, D_MODEL, 6 * D_MODEL), 0.5 * D_MODEL ** -0.5)
    b_mod = nrm(ks[5], (DEPTH, 6 * D_MODEL), 0.02)
    norm1_g = 1.0 + nrm(ks[6], (DEPTH, D_MODEL), 0.02)
    w_in = nrm(ks[7], (DEPTH, D_MODEL, IN_WIDTH), D_MODEL ** -0.5)
    hgrn_lb = nrm(ks[8], (2, DEPTH + 1, HG_HEADS * HG_DK), 0.1)
    hgrn_norm_g = 1.0 + nrm(ks[9], (DEPTH, HG_WIDTH), 0.02)
    base = jnp.log(2.0 ** (5.0 + jnp.arange(RET_HEADS, dtype=f32)) - 1.0)
    ret_decay = base + nrm(ks[10], (DEPTH, 2, RET_HEADS), 0.01)
    ret_norm_g = 1.0 + nrm(ks[11], (DEPTH, RET_WIDTH), 0.02)
    w_out = nrm(ks[12], (DEPTH, MIX_WIDTH, D_MODEL), MIX_WIDTH ** -0.5)
    norm2_g = 1.0 + nrm(ks[13], (DEPTH, D_MODEL), 0.02)
    w_up = nrm(ks[14], (DEPTH, D_MODEL, 2 * D_FF), D_MODEL ** -0.5)
    conv_w = nrm(ks[15], (DEPTH, CONV_W, D_FF), CONV_W ** -0.5)
    conv_b = nrm(ks[16], (DEPTH, D_FF), 0.01)
    w_down = nrm(ks[17], (DEPTH, D_FF, D_MODEL), D_FF ** -0.5)
    final_g = 1.0 + nrm(ks[18], (D_MODEL,), 0.02)
    return {'x': x, 'c': c, 'ctx': ctx, 'c_ctx': c_ctx, 'w_mod': w_mod, 'b_mod': b_mod,
            'norm1_g': norm1_g, 'w_in': w_in, 'hgrn_lb': hgrn_lb, 'hgrn_norm_g': hgrn_norm_g,
            'ret_decay': ret_decay, 'ret_norm_g': ret_norm_g, 'w_out': w_out, 'norm2_g': norm2_g,
            'w_up': w_up, 'conv_w': conv_w, 'conv_b': conv_b, 'w_down': w_down, 'final_g': final_g}


def reference(x, c, ctx, c_ctx, w_mod, b_mod, norm1_g, w_in, hgrn_lb, hgrn_norm_g,
              ret_decay, ret_norm_g, w_out, norm2_g, w_up, conv_w, conv_b, w_down, final_g):
    f32 = jnp.float32
    seq_len = x.shape[1]
    ROWS = seq_len // GRID_W
    rows = jnp.repeat(jnp.arange(ROWS, dtype=f32), GRID_W)
    cols = jnp.tile(jnp.arange(GRID_W, dtype=f32), ROWS)
    lb_all = jnp.cumsum(jax.nn.softmax(hgrn_lb.astype(f32), axis=1), axis=1)
    for layer in range(DEPTH):
        last = layer == DEPTH - 1
        mod_x = (jax.nn.silu(c) @ w_mod[layer] + b_mod[layer])[:, None, :]
        mod_c = jax.nn.silu(c_ctx) @ w_mod[layer] + b_mod[layer]
        sh1, sc1, g1, sh2, sc2, g2 = jnp.split(mod_x, 6, axis=-1)
        csh1, csc1, cg1, csh2, csc2, cg2 = jnp.split(mod_c, 6, axis=-1)
        lb = lb_all[:, layer].reshape(2, HG_HEADS, 1, HG_DK)
        log_gamma = jax.nn.log_sigmoid(ret_decay[layer].astype(f32))

        hx = _rmsnorm(x, norm1_g[layer]) * (1.0 + sc1) + sh1
        hc = _rmsnorm(ctx, norm1_g[layer]) * (1.0 + csc1) + csh1
        feats_x = _mixer_features(hx, w_in[layer], lb, (rows, cols))
        feats_c = _mixer_features(hc, w_in[layer], lb, None)
        if last:
            ctx_states = _context_states(feats_c, log_gamma)
        else:
            mix_c, ctx_states = _bidir_mix(feats_c, _zero_states(ctx.shape[0]), log_gamma,
                                           hgrn_norm_g[layer], ret_norm_g[layer])
        mix_x, _ = _bidir_mix(feats_x, ctx_states, log_gamma, hgrn_norm_g[layer], ret_norm_g[layer])
        x = x + g1 * (mix_x.astype(x.dtype) @ w_out[layer])

        hx2 = _rmsnorm(x, norm2_g[layer]) * (1.0 + sc2) + sh2
        x = x + g2 * _conv_ffn(hx2, w_up[layer], conv_w[layer], conv_b[layer], w_down[layer])

        if not last:
            ctx = ctx + cg1 * (mix_c.astype(ctx.dtype) @ w_out[layer])
            hc2 = _rmsnorm(ctx, norm2_g[layer]) * (1.0 + csc2) + csh2
            ctx = ctx + cg2 * _conv_ffn(hc2, w_up[layer], conv_w[layer], conv_b[layer], w_down[layer])
    return _rmsnorm(x, final_g)
```

```cpp
#include <hip/hip_runtime.h>
#include <stdint.h>

namespace nv {
constexpr int D = 1024, NB_TOT = 16, L = 2048, CL = 256, NIN = 4608, DFF = 2816, DUP = 5632;
constexpr float EPS = 1e-6f;

__device__ __forceinline__ float sigm(float x) { return 1.f / (1.f + expf(-x)); }
__device__ __forceinline__ float silu(float x) { return x / (1.f + expf(-x)); }

__global__ __launch_bounds__(256) void k_mod(const float* c, const float* c_ctx, const float* w_mod, const float* b_mod, float* mod) {
    const int n = blockIdx.x * 256 + threadIdx.x, r = blockIdx.y;
    const float* cv = r < 16 ? c + r * D : c_ctx;
    float acc = b_mod[n];
    for (int k = 0; k < D; ++k) acc += silu(cv[k]) * w_mod[(size_t)k * 6144 + n];
    mod[(size_t)r * 6144 + n] = acc;
}

__device__ __forceinline__ float block_sum256(float v, float* red) {
    for (int o = 32; o > 0; o >>= 1) v += __shfl_xor(v, o);
    const int w = threadIdx.x >> 6;
    __syncthreads();
    if ((threadIdx.x & 63) == 0) red[w] = v;
    __syncthreads();
    return red[0] + red[1] + red[2] + red[3];
}

__global__ __launch_bounds__(256) void k_norm_mod(const float* in, const float* g, const float* sc, const float* sh, int rows_per_batch, int mod_stride, float* out) {
    __shared__ float red[4];
    const int row = blockIdx.x, t = threadIdx.x;
    const float* x = in + (size_t)row * D;
    float v[4]; float s = 0.f;
    for (int i = 0; i < 4; ++i) { v[i] = x[t + 256 * i]; s += v[i] * v[i]; }
    s = block_sum256(s, red);
    const float rstd = rsqrtf(s / D + EPS);
    const int b = row / rows_per_batch;
    for (int i = 0; i < 4; ++i) {
        const int cidx = t + 256 * i;
        float y = v[i] * rstd * g[cidx];
        if (sc) y = y * (1.f + sc[(size_t)b * mod_stride + cidx]) + sh[(size_t)b * mod_stride + cidx];
        out[(size_t)row * D + cidx] = y;
    }
}

__global__ __launch_bounds__(256) void k_sgemm(const float* __restrict__ A, int lda, const float* __restrict__ Bm, int ldb, float* __restrict__ C, int ldc, int K) {
    __shared__ float As[16][132];
    __shared__ float Bs[16][132];
    const int tid = threadIdx.x, tx = tid & 15, ty = tid >> 4;
    const int bm = blockIdx.y * 128, bn = blockIdx.x * 128;
    float acc[8][8];
#pragma unroll
    for (int i = 0; i < 8; ++i)
#pragma unroll
        for (int j = 0; j < 8; ++j) acc[i][j] = 0.f;
    const int ar = tid >> 1, ak = (tid & 1) * 8;
    const int br = tid >> 4, bc = (tid & 15) * 8;
    for (int k0 = 0; k0 < K; k0 += 16) {
        const float4 a0 = *(const float4*)(A + (size_t)(bm + ar) * lda + k0 + ak);
        const float4 a1 = *(const float4*)(A + (size_t)(bm + ar) * lda + k0 + ak + 4);
        const float4 b0 = *(const float4*)(Bm + (size_t)(k0 + br) * ldb + bn + bc);
        const float4 b1 = *(const float4*)(Bm + (size_t)(k0 + br) * ldb + bn + bc + 4);
        __syncthreads();
        As[ak + 0][ar] = a0.x; As[ak + 1][ar] = a0.y; As[ak + 2][ar] = a0.z; As[ak + 3][ar] = a0.w;
        As[ak + 4][ar] = a1.x; As[ak + 5][ar] = a1.y; As[ak + 6][ar] = a1.z; As[ak + 7][ar] = a1.w;
        *(float4*)&Bs[br][bc] = b0; *(float4*)&Bs[br][bc + 4] = b1;
        __syncthreads();
#pragma unroll
        for (int kk = 0; kk < 16; ++kk) {
            float a[8], b[8];
#pragma unroll
            for (int i = 0; i < 8; ++i) a[i] = As[kk][ty * 8 + i];
#pragma unroll
            for (int j = 0; j < 8; ++j) b[j] = Bs[kk][tx * 8 + j];
#pragma unroll
            for (int i = 0; i < 8; ++i)
#pragma unroll
                for (int j = 0; j < 8; ++j) acc[i][j] += a[i] * b[j];
        }
    }
#pragma unroll
    for (int i = 0; i < 8; ++i) {
        float* cp = C + (size_t)(bm + ty * 8 + i) * ldc + bn + tx * 8;
        *(float4*)cp = make_float4(acc[i][0], acc[i][1], acc[i][2], acc[i][3]);
        *(float4*)(cp + 4) = make_float4(acc[i][4], acc[i][5], acc[i][6], acc[i][7]);
    }
}

__global__ __launch_bounds__(128) void k_scan(const float* Px, const float* Pc, int nb, const float* hgrn_lb, const float* ret_decay, float* O) {
    __shared__ float sf[2][128], sk[2][128], sq[2][128];
    const int blk = blockIdx.x, dir = blk & 1, head = (blk >> 1) & 7, bl = blk >> 4, j = threadIdx.x;
    const bool isret = head >= 4; const int h = head & 3;
    float S[128];
#pragma unroll
    for (int k = 0; k < 128; ++k) S[k] = 0.f;
    float lb = 0.f, gamma = 0.f;
    if (!isret) { const float a0 = hgrn_lb[(dir * 2 + 0) * 512 + h * 128 + j], a1 = hgrn_lb[(dir * 2 + 1) * 512 + h * 128 + j]; lb = 1.f / (1.f + expf(a1 - a0)); }
    else { gamma = sigm(ret_decay[dir * 4 + h]); }
    const int i32 = j & 31; const float freq = powf(10000.f, -(float)i32 / 32.f);
    for (int step = 0; step < CL + L; ++step) {
        const bool isctx = step < CL;
        const int tok = isctx ? (dir == 0 ? step : CL - 1 - step) : (dir == 0 ? step - CL : L - 1 - (step - CL));
        const float* prow = isctx ? Pc + (size_t)(bl * CL + tok) * NIN : Px + (size_t)(bl * L + tok) * NIN;
        float f, kk, q, v;
        if (!isret) {
            const float z = prow[(dir == 0 ? 1024 : 1536) + h * 128 + j];
            f = lb + (1.f - lb) * sigm(z); kk = 1.f - f; q = prow[h * 128 + j]; v = prow[512 + h * 128 + j];
        } else {
            f = gamma; v = prow[3584 + h * 128 + j];
            const float rq = prow[2560 + h * 128 + j], rk = prow[3072 + h * 128 + j] * 0.08838834764831845f;
            if (!isctx) {
                const int jp = j ^ 32; const bool second = (j >> 5) & 1;
                const float pos = (float)((j >> 6) == 0 ? tok / 64 : tok % 64);
                const float ang = pos * freq, cs = cosf(ang), sn = sinf(ang);
                const float rqp = prow[2560 + h * 128 + jp], rkp = prow[3072 + h * 128 + jp] * 0.08838834764831845f;
                if (!second) { q = rq * cs - rqp * sn; kk = rk * cs - rkp * sn; }
                else { q = rqp * sn + rq * cs; kk = rkp * sn + rk * cs; }
            } else { q = rq; kk = rk; }
        }
        const int p = step & 1;
        sf[p][j] = f; sk[p][j] = kk; sq[p][j] = q;
        __syncthreads();
        float o = 0.f;
#pragma unroll
        for (int k = 0; k < 128; ++k) { S[k] = sf[p][k] * S[k] + sk[p][k] * v; o += S[k] * sq[p][k]; }
        if (!isctx) O[((size_t)dir * nb * L + (size_t)bl * L + tok) * D + head * 128 + j] = o;
    }
}

__global__ __launch_bounds__(128) void k_combine(const float* O, int nrows, const float* Px, const float* hg_g, const float* ret_g, float* mixed) {
    __shared__ float red[2];
    const int row = blockIdx.x >> 3, head = blockIdx.x & 7, v = threadIdx.x;
    const bool isret = head >= 4; const int h = head & 3;
    float s = O[(size_t)row * D + head * 128 + v] + O[((size_t)nrows + row) * D + head * 128 + v];
    const float* prow = Px + (size_t)row * NIN;
    if (!isret) s *= sigm(prow[2048 + h * 128 + v]);
    float q = s * s;
    for (int o = 32; o > 0; o >>= 1) q += __shfl_xor(q, o);
    if ((v & 63) == 0) red[v >> 6] = q;
    __syncthreads();
    const float rstd = rsqrtf((red[0] + red[1]) / 128.f + EPS);
    float y;
    if (!isret) y = s * rstd * hg_g[h * 128 + v];
    else y = s * rstd * ret_g[h * 128 + v] * silu(prow[4096 + h * 128 + v]);
    mixed[(size_t)row * D + head * 128 + v] = y;
}

__global__ __launch_bounds__(256) void k_resid(const float* base, const float* T, const float* gate, int rows_per_batch, int mod_stride, float* out) {
    const int row = blockIdx.x, b = row / rows_per_batch;
    for (int i = 0; i < 4; ++i) { const int c = threadIdx.x + 256 * i; out[(size_t)row * D + c] = base[(size_t)row * D + c] + gate[(size_t)b * mod_stride + c] * T[(size_t)row * D + c]; }
}

__global__ __launch_bounds__(256) void k_conv(const float* H, const float* cw, const float* cb, float* hid) {
    const int row = blockIdx.x, t = row % L;
    for (int c = threadIdx.x; c < DFF; c += 256) {
        const float g0 = t > 0 ? H[(size_t)(row - 1) * DUP + c] : 0.f, g1 = H[(size_t)row * DUP + c], g2 = t < L - 1 ? H[(size_t)(row + 1) * DUP + c] : 0.f;
        const float g = cw[c] * g0 + cw[DFF + c] * g1 + cw[2 * DFF + c] * g2 + cb[c];
        hid[(size_t)row * DFF + c] = silu(g) * H[(size_t)row * DUP + DFF + c];
    }
}
}

extern "C" void kernel_launch(void* const* d_in, const int* in_sizes, int n_in, void* d_out, int out_size, void* d_ws, size_t ws_size, hipStream_t stream) {
    using namespace nv;
    const float* x = (const float*)d_in[0]; const float* c = (const float*)d_in[1]; const float* ctx = (const float*)d_in[2]; const float* c_ctx = (const float*)d_in[3];
    const float* w_mod = (const float*)d_in[4]; const float* b_mod = (const float*)d_in[5]; const float* norm1_g = (const float*)d_in[6]; const float* w_in = (const float*)d_in[7];
    const float* hgrn_lb = (const float*)d_in[8]; const float* hgrn_norm_g = (const float*)d_in[9]; const float* ret_decay = (const float*)d_in[10]; const float* ret_norm_g = (const float*)d_in[11];
    const float* w_out = (const float*)d_in[12]; const float* norm2_g = (const float*)d_in[13]; const float* w_up = (const float*)d_in[14]; const float* conv_w = (const float*)d_in[15];
    const float* conv_b = (const float*)d_in[16]; const float* w_down = (const float*)d_in[17]; const float* final_g = (const float*)d_in[18];
    float* out = (float*)d_out;
    constexpr int NB = 2;
    constexpr size_t MiB = 1u << 20;
    char* ws = (char*)d_ws;
    float* MOD = (float*)(ws);
    float* HX = (float*)(ws + 1 * MiB);
    float* HC = (float*)(ws + 17 * MiB);
    float* PX = (float*)(ws + 19 * MiB);
    float* PC = (float*)(ws + 91 * MiB);
    float* OO = (float*)(ws + 100 * MiB);
    float* MIX = (float*)(ws + 132 * MiB);
    float* TT = (float*)(ws + 148 * MiB);
    float* X1 = (float*)(ws + 164 * MiB);
    float* HX2 = (float*)(ws + 180 * MiB);
    float* HH = (float*)(ws + 196 * MiB);
    float* HID = (float*)(ws + 284 * MiB);
    float* X2 = (float*)(ws + 328 * MiB);

    k_mod<<<dim3(6144 / 256, 17), 256, 0, stream>>>(c, c_ctx, w_mod, b_mod, MOD);
    for (int pass = 0; pass < NB_TOT / NB; ++pass) {
        const int b0 = pass * NB, rows = NB * L, crows = NB * CL;
        const float* xp = x + (size_t)b0 * L * D; const float* cp = ctx + (size_t)b0 * CL * D; float* op = out + (size_t)b0 * L * D;
        const float* modb = MOD + (size_t)b0 * 6144; const float* modc = MOD + (size_t)16 * 6144;
        k_norm_mod<<<rows, 256, 0, stream>>>(xp, norm1_g, modb + 1024, modb, L, 6144, HX);
        k_norm_mod<<<crows, 256, 0, stream>>>(cp, norm1_g, modc + 1024, modc, 1 << 30, 0, HC);
        k_sgemm<<<dim3(NIN / 128, rows / 128), 256, 0, stream>>>(HX, D, w_in, NIN, PX, NIN, D);
        k_sgemm<<<dim3(NIN / 128, crows / 128), 256, 0, stream>>>(HC, D, w_in, NIN, PC, NIN, D);
        k_scan<<<NB * 16, 128, 0, stream>>>(PX, PC, NB, hgrn_lb, ret_decay, OO);
        k_combine<<<rows * 8, 128, 0, stream>>>(OO, rows, PX, hgrn_norm_g, ret_norm_g, MIX);
        k_sgemm<<<dim3(D / 128, rows / 128), 256, 0, stream>>>(MIX, D, w_out, D, TT, D, D);
        k_resid<<<rows, 256, 0, stream>>>(xp, TT, modb + 2048, L, 6144, X1);
        k_norm_mod<<<rows, 256, 0, stream>>>(X1, norm2_g, modb + 4096, modb + 3072, L, 6144, HX2);
        k_sgemm<<<dim3(DUP / 128, rows / 128), 256, 0, stream>>>(HX2, D, w_up, DUP, HH, DUP, D);
        k_conv<<<rows, 256, 0, stream>>>(HH, conv_w, conv_b, HID);
        k_sgemm<<<dim3(D / 128, rows / 128), 256, 0, stream>>>(HID, DFF, w_down, D, TT, D, DFF);
        k_resid<<<rows, 256, 0, stream>>>(X1, TT, modb + 5120, L, 6144, X2);
        k_norm_mod<<<rows, 256, 0, stream>>>(X2, final_g, nullptr, nullptr, L, 6144, op);
    }
}
```

```cpp
#include <hip/hip_runtime.h>
#include <cstdio>
#include <cstdint>
namespace pg8 {
#define PG8_LAS __attribute__((address_space(3)))
typedef unsigned short bf16_t;
typedef short bf16x8 __attribute__((ext_vector_type(8)));
typedef float f32x4 __attribute__((ext_vector_type(4)));
typedef unsigned u32x4 __attribute__((ext_vector_type(4)));
constexpr int BM = 256, BK = 64, HALF = 128, HTB = HALF * BK * 2  , STAGE_BYTES = 8 * HTB, NXCD = 8, WGM = 8;

__host__ __device__ __forceinline__ int lds_byte(int r, int c) { const int st = (r >> 4) * 2 + (c >> 5), rr = r & 15, cc = c & 31, ob = rr * 64 + cc * 2; return st * 1024 + (ob ^ (((ob >> 9) & 1) << 5)); }
__host__ __device__ __forceinline__ void stage_rc(int b, int& R, int& C) { const int st = b / 1024, sb = b % 1024, swz = sb ^ (((sb >> 9) & 1) << 5); R = (st >> 1) * 16 + swz / 64; C = (st & 1) * 32 + (swz % 64) / 2; }
__host__ __device__ __forceinline__ int perm32(int rho) { const int n = rho >> 4, i = rho & 15; return 8 * (i >> 2) + 4 * n + (i & 3); }

struct Unit { int pm, pn; };
struct Gemm { const bf16_t* A; const bf16_t* Bt; int M, N, K; };

struct StaticOrder {
    int nM, nN, nwg, G, c;
    __host__ __device__ void init(int M, int N, int G_, int c_) { nM = M / BM; nN = N / BM; nwg = nM * nN; G = G_; c = c_; }
    __host__ __device__ bool next(int i, Unit& u) const {
        const long L = (long)i * G + c; if (L >= nwg) return false;
        int wgid = (int)L; { const int q = nwg / NXCD, r = nwg % NXCD, xcd = wgid % NXCD, off = wgid / NXCD; wgid = (xcd < r ? xcd * (q + 1) : r * (q + 1) + (xcd - r) * q) + off; }
        const int nig = WGM * nN, gid = wgid / nig, fm = gid * WGM, gsz = (nM - fm) < WGM ? (nM - fm) : WGM;
        u.pm = fm + ((wgid % nig) % gsz); u.pn = (wgid % nig) / gsz; return true;
    }
    __device__ __forceinline__ void a_ready(const Unit&) const {}
    __device__ __forceinline__ void done(const Unit&) const {}
};

__device__ __forceinline__ unsigned cvt_pk_bf16(float lo, float hi) { unsigned r; asm volatile("v_cvt_pk_bf16_f32 %0, %1, %2" : "=v"(r) : "v"(lo), "v"(hi)); return r; }

template <class Epi, class Sched, bool ALIGN_EPI = false, bool SP2 = false>
__device__ __forceinline__ void gemm_phase(PG8_LAS unsigned char* lds, const Gemm g, const Sched& S, const Epi& E) {
    const int tid = threadIdx.x, wid = __builtin_amdgcn_readfirstlane(tid >> 6), lane = tid & 63, wr = wid >> 2, wc = wid & 3, fr = lane & 15, fq = lane >> 4;
    const int K = g.K, nt = K / BK;
    unsigned voffA[2], voffB[2];
#pragma unroll
    for (int i = 0; i < 2; ++i) { int R, C; stage_rc(tid * 16 + i * 8192, R, C); const int Rb = Epi::PERM ? ((R & ~31) + perm32(R & 31)) : R;
        voffA[i] = (unsigned)(R * K + C) * 2u; voffB[i] = (unsigned)(Rb * K + C) * 2u; }
    const size_t kstep = (size_t)(BK * 2);
    const size_t hstep = (size_t)HALF * K * 2;
    const size_t tstep = 2 * hstep;
    const unsigned ldsw = (unsigned)wid * 1024u;
    const int aoff = lds_byte(wr * 64 + fr, fq * 8), boff = lds_byte(wc * 32 + fr, fq * 8);
#define PG8_SA(b, h) (((b) * 2 + (h)) * HTB)
#define PG8_SB(b, h) ((4 + (b) * 2 + (h)) * HTB)
#define PG8_STAGE(bufoff, gbase, voff) do { _Pragma("unroll") for (int _i = 0; _i < 2; ++_i) \
        __builtin_amdgcn_global_load_lds((const unsigned*)((const char*)(gbase) + (voff)[_i]), (PG8_LAS unsigned*)(lds + (bufoff) + ldsw + _i * 8192), 16, 0, 0); } while (0)
#define PG8_LDA(dst, b, h) do { _Pragma("unroll") for (int m = 0; m < 4; ++m) _Pragma("unroll") for (int k = 0; k < 2; ++k) dst[m][k] = *(const PG8_LAS bf16x8*)(lds + PG8_SA(b, h) + aoff + m * 2048 + k * 1024); } while (0)
#define PG8_LDB(dst, b, h) do { _Pragma("unroll") for (int n = 0; n < 2; ++n) _Pragma("unroll") for (int k = 0; k < 2; ++k) dst[n][k] = *(const PG8_LAS bf16x8*)(lds + PG8_SB(b, h) + boff + n * 2048 + k * 1024); } while (0)
#define PG8_MMA(ai, bj, At, Bt) do { __builtin_amdgcn_s_setprio(1); _Pragma("unroll") for (int m = 0; m < 4; ++m) _Pragma("unroll") for (int n = 0; n < 2; ++n) _Pragma("unroll") for (int k = 0; k < 2; ++k) \
        acc[ai][bj][m][n] = __builtin_amdgcn_mfma_f32_16x16x32_bf16(Bt[n][k], At[m][k], acc[ai][bj][m][n], 0, 0, 0); __builtin_amdgcn_s_setprio(0); } while (0)
#define PG8_WAIT_V(n) asm volatile("s_waitcnt vmcnt(" #n ")" ::: "memory")
#define PG8_WAIT_L(n) asm volatile("s_waitcnt lgkmcnt(" #n ")" ::: "memory")
#define PG8_BAR __builtin_amdgcn_s_barrier()
#define PG8_SCHED __builtin_amdgcn_sched_barrier(0)
    Unit cur, nxt; int ui = 0;
    if (!S.next(0, cur)) return;
    f32x4 acc[2][2][4][2];
#pragma unroll
    for (int a = 0; a < 2; ++a)
#pragma unroll
        for (int b = 0; b < 2; ++b)
#pragma unroll
            for (int m = 0; m < 4; ++m)
#pragma unroll
                for (int n = 0; n < 2; ++n) acc[a][b][m][n] = (f32x4){0.f, 0.f, 0.f, 0.f};
    bf16x8 At[4][2], B0[2][2], B1[2][2];
    const char* cA = (const char*)g.A + (size_t)cur.pm * tstep; const char* cB = (const char*)g.Bt + (size_t)cur.pn * tstep;
    S.a_ready(cur);
    if constexpr (SP2) {
        PG8_STAGE(PG8_SB(0, 0), cB, voffB); PG8_STAGE(PG8_SB(0, 1), cB + hstep, voffB); PG8_STAGE(PG8_SA(0, 0), cA, voffA); PG8_STAGE(PG8_SA(0, 1), cA + hstep, voffA);
        if (wr == 1) PG8_BAR;
        PG8_WAIT_V(2); PG8_BAR;
        PG8_STAGE(PG8_SB(1, 0), cB + kstep, voffB); PG8_STAGE(PG8_SA(1, 0), cA + kstep, voffA); PG8_STAGE(PG8_SB(1, 1), cB + hstep + kstep, voffB);
        PG8_WAIT_V(6); PG8_BAR;
    } else {
        PG8_STAGE(PG8_SB(0, 0), cB, voffB); PG8_STAGE(PG8_SA(0, 0), cA, voffA); PG8_STAGE(PG8_SB(0, 1), cB + hstep, voffB); PG8_STAGE(PG8_SA(0, 1), cA + hstep, voffA);
        if (wr == 1) PG8_BAR;
        PG8_WAIT_V(4); PG8_BAR;
        PG8_STAGE(PG8_SB(1, 0), cB + kstep, voffB); PG8_STAGE(PG8_SA(1, 0), cA + kstep, voffA); PG8_STAGE(PG8_SB(1, 1), cB + hstep + kstep, voffB);
        PG8_WAIT_V(6); PG8_BAR;
    }
    for (;;) {
        const bool has_next = S.next(ui + 1, nxt);
        const char* nA = has_next ? (const char*)g.A + (size_t)nxt.pm * tstep : cA; const char* nB = has_next ? (const char*)g.Bt + (size_t)nxt.pn * tstep : cB;
        for (int t = 0; t < nt; t += 2) {
            const bool last = (t == nt - 2);
            const char* a1 = cA + (size_t)(t + 1) * kstep;
            const char* a2 = last ? nA : cA + (size_t)(t + 2) * kstep; const char* b2 = last ? nB : cB + (size_t)(t + 2) * kstep;
            const char* a3 = a2 + kstep; const char* b3 = b2 + kstep;
            if (last && has_next) S.a_ready(nxt);
            if constexpr (SP2) {
            PG8_LDB(B0, 0, 0); PG8_LDB(B1, 0, 1); PG8_SCHED; PG8_LDA(At, 0, 0); PG8_STAGE(PG8_SA(1, 1), a1 + hstep, voffA);
            PG8_WAIT_V(8); PG8_WAIT_L(0); PG8_BAR; PG8_MMA(0, 0, At, B0); PG8_MMA(0, 1, At, B1); PG8_BAR; PG8_SCHED;
            PG8_LDA(At, 0, 1); PG8_STAGE(PG8_SB(0, 0), b2, voffB); PG8_STAGE(PG8_SB(0, 1), b2 + hstep, voffB); PG8_STAGE(PG8_SA(0, 0), a2, voffA);
            PG8_WAIT_V(8); PG8_WAIT_L(0); PG8_BAR; PG8_MMA(1, 0, At, B0); PG8_MMA(1, 1, At, B1); PG8_BAR; PG8_SCHED;
            PG8_LDB(B0, 1, 0); PG8_LDB(B1, 1, 1); PG8_SCHED; PG8_LDA(At, 1, 0); PG8_STAGE(PG8_SA(0, 1), a2 + hstep, voffA);
            PG8_WAIT_V(8); PG8_WAIT_L(0); PG8_BAR; PG8_MMA(0, 0, At, B0); PG8_MMA(0, 1, At, B1); PG8_BAR; PG8_SCHED;
            PG8_LDA(At, 1, 1); PG8_STAGE(PG8_SB(1, 0), b3, voffB); PG8_STAGE(PG8_SB(1, 1), b3 + hstep, voffB); PG8_STAGE(PG8_SA(1, 0), a3, voffA);
            PG8_WAIT_V(8); PG8_WAIT_L(0); PG8_BAR; PG8_MMA(1, 0, At, B0); PG8_MMA(1, 1, At, B1); PG8_BAR; PG8_SCHED;
            } else {
            PG8_LDB(B0, 0, 0); PG8_SCHED; PG8_LDA(At, 0, 0); PG8_STAGE(PG8_SA(1, 1), a1 + hstep, voffA);
            PG8_WAIT_L(8); PG8_BAR; PG8_WAIT_L(0); PG8_MMA(0, 0, At, B0); PG8_BAR; PG8_SCHED;
            PG8_LDB(B1, 0, 1); PG8_STAGE(PG8_SB(0, 0), b2, voffB);
            PG8_BAR; PG8_WAIT_L(0); PG8_MMA(0, 1, At, B1); PG8_BAR;
            PG8_LDA(At, 0, 1); PG8_STAGE(PG8_SA(0, 0), a2, voffA);
            PG8_BAR; PG8_WAIT_L(0); PG8_MMA(1, 0, At, B0); PG8_BAR; PG8_SCHED;
            PG8_STAGE(PG8_SB(0, 1), b2 + hstep, voffB);
            PG8_WAIT_V(6); PG8_BAR; PG8_MMA(1, 1, At, B1); PG8_BAR;
            PG8_LDB(B0, 1, 0); PG8_SCHED; PG8_LDA(At, 1, 0); PG8_STAGE(PG8_SA(0, 1), a2 + hstep, voffA);
            PG8_WAIT_L(8); PG8_BAR; PG8_WAIT_L(0); PG8_MMA(0, 0, At, B0); PG8_BAR; PG8_SCHED;
            PG8_LDB(B1, 1, 1); PG8_STAGE(PG8_SB(1, 0), b3, voffB);
            PG8_BAR; PG8_WAIT_L(0); PG8_MMA(0, 1, At, B1); PG8_BAR;
            PG8_LDA(At, 1, 1); PG8_STAGE(PG8_SA(1, 0), a3, voffA);
            PG8_BAR; PG8_WAIT_L(0); PG8_MMA(1, 0, At, B0); PG8_BAR; PG8_SCHED;
            PG8_STAGE(PG8_SB(1, 1), b3 + hstep, voffB);
            PG8_WAIT_V(6); PG8_BAR; PG8_MMA(1, 1, At, B1); PG8_BAR;
            }
        }
        if constexpr (ALIGN_EPI) { if (wr == 0) PG8_BAR; }
        if constexpr (!Epi::AFTER_DRAIN) { E(acc, cur, wr, wc, fr, fq); S.done(cur); }
        if (!has_next) break;
#pragma unroll
        for (int a = 0; a < 2; ++a)
#pragma unroll
            for (int b = 0; b < 2; ++b)
#pragma unroll
                for (int m = 0; m < 4; ++m)
#pragma unroll
                    for (int n = 0; n < 2; ++n) acc[a][b][m][n] = (f32x4){0.f, 0.f, 0.f, 0.f};
        cur = nxt; cA = nA; cB = nB; ++ui;
        if constexpr (ALIGN_EPI) { if (wr == 1) PG8_BAR; }
    }
    PG8_WAIT_V(0);
    if constexpr (!ALIGN_EPI) { if (wr == 0) PG8_BAR; }
    PG8_BAR;
    if constexpr (Epi::AFTER_DRAIN) { E.fused(acc, cur, wr, wc, fr, fq, lds, wid, lane); S.done(cur); }
#undef PG8_SA
#undef PG8_SB
#undef PG8_STAGE
#undef PG8_LDA
#undef PG8_LDB
#undef PG8_MMA
#undef PG8_WAIT_V
#undef PG8_WAIT_L
#undef PG8_BAR
#undef PG8_SCHED
}

}

constexpr int NWAVES = 8;
constexpr int D = 1024, NBATCH = 16, L = 2048, CL = 256, M = NBATCH * L, MC = NBATCH * CL, MT = M + MC, NIN = 4608, DFF = 2816, DUP = 5632;
constexpr float EPS = 1e-6f;
constexpr int N_PHASES = 10;
constexpr int MAX_LAUNCH = 4;

constexpr size_t MiB = 1u << 20;
constexpr size_t WS_CTL = 0, CTL_ZERO_BYTES = 1 * MiB;
constexpr size_t WS_MOD = 1 * MiB;
constexpr size_t WS_BIAS2 = 1 * MiB + 512 * 1024;
constexpr size_t WS_ROPE = 2 * MiB;
constexpr size_t WS_WIN = 3 * MiB, WS_WOUT = 12 * MiB, WS_WUP = 14 * MiB, WS_WDN = 25 * MiB;
constexpr size_t WS_DF = 31 * MiB, WS_DB = 32 * MiB + 512 * 1024;
constexpr size_t WS_SSQ1 = 34 * MiB;
constexpr size_t WS_EDGEG = 36 * MiB;
constexpr size_t WS_EDGEU = 58 * MiB;
constexpr size_t WS_KF = 72 * MiB, WS_KB = 144 * MiB, WS_V = 216 * MiB;
constexpr size_t WS_QF = 288 * MiB, WS_QB = 352 * MiB, WS_G = 416 * MiB;
constexpr size_t WS_MIXED = WS_G, WS_A2 = WS_QF, WS_HID = WS_KF;
constexpr size_t WS_END = 480 * MiB;
constexpr int CW_BAR = 4096;

constexpr int RING_OFF = 0, RING_BYTES = 131072;
constexpr int LDSCTL_OFF = RING_BYTES, MISC_OFF = LDSCTL_OFF + 320;
constexpr int LDS_BYTES = 147456;

#define GAS __attribute__((address_space(1)))
#define LAS __attribute__((address_space(3)))
typedef unsigned short bf16;
typedef unsigned v4u __attribute__((ext_vector_type(4)));
typedef unsigned v2u __attribute__((ext_vector_type(2)));
typedef float f32x4 __attribute__((ext_vector_type(4)));
typedef short bf16x8 __attribute__((ext_vector_type(8)));
typedef GAS unsigned gu32;
#define RLX_AGENT __ATOMIC_RELAXED, __HIP_MEMORY_SCOPE_AGENT
#define LDS_WAIT() asm volatile("s_waitcnt lgkmcnt(0)" ::: "memory")
#define VM_WAIT() asm volatile("s_waitcnt vmcnt(0)" ::: "memory")
__device__ __forceinline__ unsigned f2bf(float f) { unsigned u = __builtin_bit_cast(unsigned, f); return (u + 0x7fffu + ((u >> 16) & 1u)) >> 16; }
__device__ __forceinline__ unsigned pk2(float lo, float hi) { return f2bf(lo) | (f2bf(hi) << 16); }
__device__ __forceinline__ float bf2f(unsigned short h) { return __builtin_bit_cast(float, (unsigned)h << 16); }
__device__ __forceinline__ float sigm(float x) { return 1.f / (1.f + __expf(-x)); }
__device__ __forceinline__ float siluf(float x) { return x / (1.f + __expf(-x)); }

#define XB_TMO      128
#define XB_XCNT(j)  (256  + 64 * (j))
#define XB_XSUB(j)  (1280 + 64 * (j))
#define XB_XGEN(j)  (2304 + 64 * (j))
#define XB_TOP      3328
#define XB_TOPGEN   3392
#define XCD_BAR_WORDS 3456
#define XB_SPIN_CAP (1u << 18)

__device__ __forceinline__ unsigned xb_ld(unsigned* p)              { return __hip_atomic_load(p, __ATOMIC_RELAXED, __HIP_MEMORY_SCOPE_AGENT); }
__device__ __forceinline__ unsigned xb_add(unsigned* p, unsigned v) { return __hip_atomic_fetch_add(p, v, __ATOMIC_RELAXED, __HIP_MEMORY_SCOPE_AGENT); }
__device__ __forceinline__ unsigned xb_xcc_id() { return (unsigned)__builtin_amdgcn_s_getreg((3 << 11) | 20) & 0xFu; }
#define XB_SPIN(cond, bar) do { unsigned _sp = 0; while (cond) { __builtin_amdgcn_s_sleep(1); \
    if ((++_sp & 255u) == 0u) { if (xb_ld(&(bar)[XB_TMO])) break; if (_sp > XB_SPIN_CAP) { atomicAdd(&(bar)[XB_TMO], 1u); break; } } } } while (0)

struct XcdBarrier {
    unsigned* bar; unsigned x;
    volatile LAS unsigned* st;
};

__device__ __forceinline__ XcdBarrier xcd_barrier_post(unsigned* bar, volatile LAS unsigned* st) {
    XcdBarrier b; b.bar = bar; b.x = xb_xcc_id(); b.st = st;
    if (threadIdx.x == 0) (void)xb_add(&bar[XB_XCNT(b.x)], 1u);
    return b;
}
__device__ __forceinline__ void xcd_barrier_complete(unsigned* bar, unsigned x, unsigned& nloc, unsigned& nx) {
    const unsigned G = gridDim.x * gridDim.y * gridDim.z;
    unsigned sum, cnt, mine, sp = 0u;
    for (;;) {
        sum = 0u; cnt = 0u; mine = 0u;
#pragma unroll
        for (unsigned j = 0; j < 16; ++j) { const unsigned c = xb_ld(&bar[XB_XCNT(j)]); sum += c; cnt += (c > 0u) ? 1u : 0u; mine = (j == x) ? c : mine; }
        if (sum == G) break;
        __builtin_amdgcn_s_sleep(1);
        if ((++sp & 255u) == 0u) { if (xb_ld(&bar[XB_TMO])) break; if (sp > XB_SPIN_CAP) { atomicAdd(&bar[XB_TMO], 1u); break; } }
    }
    nloc = mine > 0u ? mine : 1u; nx = cnt > 0u ? cnt : 1u;
}

__device__ __forceinline__ void xcd_barrier(const XcdBarrier& b) {
    asm volatile("s_waitcnt vmcnt(0)" ::: "memory");
    __syncthreads();
    if (threadIdx.x == 0) {
        unsigned* bar = b.bar;
        __builtin_amdgcn_s_waitcnt(0);
        unsigned nloc = b.st[0], nx = b.st[1];
        if (nloc == 0u) { xcd_barrier_complete(bar, b.x, nloc, nx); b.st[0] = nloc; b.st[1] = nx; }
        const unsigned old = xb_add(&bar[XB_XSUB(b.x)], 1u);
        const unsigned gen = old / nloc;
        if (old + 1u == (gen + 1u) * nloc) {
            __builtin_amdgcn_fence(__ATOMIC_RELEASE, "agent");
            asm volatile("s_waitcnt vmcnt(0)" ::: "memory");
            const unsigned og = xb_add(&bar[XB_TOP], 1u);
            const unsigned tg = og / nx;
            if (og + 1u == (tg + 1u) * nx) xb_add(&bar[XB_TOPGEN], 1u);
            else XB_SPIN(xb_ld(&bar[XB_TOPGEN]) == tg, bar);
            __builtin_amdgcn_fence(__ATOMIC_ACQUIRE, "agent");
            xb_add(&bar[XB_XGEN(b.x)], 1u);
            asm volatile("s_waitcnt vmcnt(0)" ::: "memory");
        } else {
            XB_SPIN(xb_ld(&bar[XB_XGEN(b.x)]) == gen, bar);
            __builtin_amdgcn_fence(__ATOMIC_ACQUIRE, "agent");
            asm volatile("s_waitcnt vmcnt(0)" ::: "memory");
        }
    }
    __syncthreads();
}


struct Frame {
    LAS unsigned char* lds;
    volatile LAS unsigned* MISC;
    gu32* ctl;
    int tid, lane, wave;
    int vcu, G;
    unsigned char* ws;
    const float *x, *c, *ctx, *c_ctx, *w_mod, *b_mod, *norm1_g, *w_in, *hgrn_lb, *hgrn_norm_g, *ret_decay, *ret_norm_g, *w_out, *norm2_g, *w_up, *conv_w, *conv_b, *w_down, *final_g;
    float* out;
};
__device__ __forceinline__ float wave_sum(float v) {
#pragma unroll
    for (int o = 1; o < 64; o <<= 1) v += __shfl_xor(v, o);
    return v;
}

__device__ __forceinline__ int ropeperm(int p) { const int half = p >> 6, pp = p & 63; return 64 * half + (pp >> 1) + 32 * (pp & 1); }
__device__ __forceinline__ int win_colmap(int phys) {
    const int tile = phys >> 8, c = phys & 255;
    if (tile < 8) {
        const int h = tile >> 1, kh = tile & 1, bj = c >> 7, cc = c & 127, jp = cc >> 3, n = (cc >> 2) & 1, i = cc & 3, key = 64 * kh + 4 * jp + i;
        const int grp = bj == 0 ? (n == 0 ? 0 : 1024) : (n == 0 ? 1536 : 512);
        return grp + h * 128 + key;
    }
    if (tile < 10) return 2048 + (tile - 8) * 256 + c;
    if (tile < 12) return 2560 + (2 * (tile - 10) + (c >> 7)) * 128 + ropeperm(c & 127);
    if (tile < 14) return 3072 + (2 * (tile - 12) + (c >> 7)) * 128 + ropeperm(c & 127);
    if (tile < 16) return 3584 + (tile - 14) * 256 + c;
    return 4096 + (tile - 16) * 256 + c;
}
__device__ __forceinline__ int wup_colmap(int phys) { const int j = phys >> 8, c = phys & 255; return c < 128 ? 128 * j + c : DFF + 128 * j + (c - 128); }

template <int MAP>
__device__ __forceinline__ void p0_transpose_item(const float* W, int K, int N, bf16* WT, LAS float* scr, int item, int lane) {
    const int nblk = N / 32, kb = item / nblk, nb = item % nblk, k0 = 64 * kb, n0 = 32 * nb;
    const int nphys = n0 + (lane & 31);
    const int ncol = MAP == 0 ? nphys : (MAP == 1 ? win_colmap(nphys) : wup_colmap(nphys));
#pragma unroll 8
    for (int i = 0; i < 32; ++i) { const int kk = 2 * i + (lane >> 5); scr[kk * 33 + (lane & 31)] = W[(size_t)(k0 + kk) * N + ncol]; }
    LDS_WAIT(); asm volatile("" ::: "memory");
    const int c = lane & 7;
#pragma unroll
    for (int j = 0; j < 4; ++j) { const int n = (lane >> 3) + 8 * j; const LAS float* s = scr + (8 * c) * 33 + n;
        v4u o; o.x = pk2(s[0 * 33], s[1 * 33]); o.y = pk2(s[2 * 33], s[3 * 33]); o.z = pk2(s[4 * 33], s[5 * 33]); o.w = pk2(s[6 * 33], s[7 * 33]);
        *(GAS v4u*)(WT + (size_t)(n0 + n) * K + k0 + 8 * c) = o; }
    LDS_WAIT(); asm volatile("" ::: "memory");
}

__device__ __forceinline__ void p0_mod(Frame& F, int cg) {
    LAS float* scr = (LAS float*)(F.lds) + F.wave * (17 * 128);
    LAS float* red = (LAS float*)(F.lds + 8 * 17 * 128 * 4);
    float* MOD = (float*)(F.ws + WS_MOD);
    const int k0 = F.wave * 128;
    for (int r = 0; r < 17; ++r)
        for (int kk = F.lane; kk < 128; kk += 64) { const float cv = r < 16 ? F.c[r * D + k0 + kk] : F.c_ctx[k0 + kk]; scr[r * 128 + kk] = cv / (1.f + expf(-cv)); }
    LDS_WAIT(); asm volatile("" ::: "memory");
    float acc[17];
#pragma unroll
    for (int r = 0; r < 17; ++r) acc[r] = 0.f;
    const float* wp = F.w_mod + (size_t)k0 * 6144 + cg * 64 + F.lane;
#pragma unroll 8
    for (int kk = 0; kk < 128; ++kk) { const float w = wp[(size_t)kk * 6144];
#pragma unroll
        for (int r = 0; r < 17; ++r) acc[r] += scr[r * 128 + kk] * w; }
#pragma unroll
    for (int r = 0; r < 17; ++r) red[(F.wave * 17 + r) * 64 + F.lane] = acc[r];
    __syncthreads();
    for (int o = F.tid; o < 17 * 64; o += NWAVES * 64) { const int r = o >> 6, cc = o & 63; float s = F.b_mod[cg * 64 + cc];
#pragma unroll
        for (int w = 0; w < 8; ++w) s += red[(w * 17 + r) * 64 + cc];
        MOD[(size_t)r * 6144 + cg * 64 + cc] = s; }
    __syncthreads();
}

__device__ __forceinline__ void p0_prologue(Frame& F) {
    if (F.vcu < 96) p0_mod(F, F.vcu);
    if (F.vcu == 96) {
        float2* T = (float2*)(F.ws + WS_ROPE);
        for (int e = F.tid; e < 64 * 32; e += NWAVES * 64) { const int pos = e >> 5, i = e & 31; const float ang = (float)pos * powf(10000.f, -(float)i / 32.f); T[e] = make_float2(cosf(ang), sinf(ang)); }
    }
    LAS float* scr = (LAS float*)(F.lds + RING_OFF + F.wave * 16384);
    const int gw = F.vcu * NWAVES + F.wave, NGW = F.G * NWAVES;
    constexpr int I_IN = (D / 64) * (NIN / 32), I_O = (D / 64) * (D / 32), I_UP = (D / 64) * (DUP / 32), I_DN = (DFF / 64) * (D / 32);
    constexpr int NITEMS = I_IN + I_O + I_UP + I_DN;
    for (int it = gw; it < NITEMS; it += NGW) {
        int r = it;
        if (r < I_IN) { p0_transpose_item<1>(F.w_in, D, NIN, (bf16*)(F.ws + WS_WIN), scr, r, F.lane); continue; } r -= I_IN;
        if (r < I_O) { p0_transpose_item<0>(F.w_out, D, D, (bf16*)(F.ws + WS_WOUT), scr, r, F.lane); continue; } r -= I_O;
        if (r < I_UP) { p0_transpose_item<2>(F.w_up, D, DUP, (bf16*)(F.ws + WS_WUP), scr, r, F.lane); continue; } r -= I_UP;
        p0_transpose_item<0>(F.w_down, DFF, D, (bf16*)(F.ws + WS_WDN), scr, r, F.lane);
    }
}

__device__ __forceinline__ void p0b_phase(Frame& F, bf16* xn) {
    const int gw = F.vcu * NWAVES + F.wave, NGW = F.G * NWAVES;
    const float* MOD = (const float*)(F.ws + WS_MOD);
    {
        const int per = (MT + NGW - 1) / NGW, r0 = gw * per, r1 = (r0 + per) < MT ? (r0 + per) : MT;
        int curb = -1; f32x4 gs[4], sh[4];
        for (int m = r0; m < r1; ++m) {
            const int bidx = m < M ? m / L : 16;
            if (bidx != curb) {
#pragma unroll
                for (int j = 0; j < 4; ++j) { const int k = 4 * F.lane + 256 * j; const f32x4 g = *(const f32x4*)(F.norm1_g + k), sc = *(const f32x4*)(MOD + (size_t)bidx * 6144 + 1024 + k);
                    gs[j] = g * (1.f + sc); sh[j] = *(const f32x4*)(MOD + (size_t)bidx * 6144 + k); }
                curb = bidx;
            }
            const float* xrow = m < M ? F.x + (size_t)m * D : F.ctx + (size_t)(m - M) * D;
            const GAS f32x4* xr = (const GAS f32x4*)xrow + F.lane;
            f32x4 v[4]; float s = 0.f;
#pragma unroll
            for (int j = 0; j < 4; ++j) { v[j] = xr[64 * j]; s += (v[j].x * v[j].x + v[j].y * v[j].y) + (v[j].z * v[j].z + v[j].w * v[j].w); }
            const float rstd = rsqrtf(wave_sum(s) * (1.f / D) + EPS);
            GAS v2u* o8 = (GAS v2u*)(xn + (size_t)m * D) + F.lane;
#pragma unroll
            for (int j = 0; j < 4; ++j) { const f32x4 y = v[j] * rstd * gs[j] + sh[j]; v2u w; w.x = pk2(y.x, y.y); w.y = pk2(y.z, y.w); o8[64 * j] = w; }
        }
    }
    {
        const bf16* WUP = (const bf16*)(F.ws + WS_WUP); float* B2 = (float*)(F.ws + WS_BIAS2);
        for (int n = gw; n < DUP; n += NGW) {
            float wf[16];
#pragma unroll
            for (int j = 0; j < 2; ++j) { const v4u w = *(const GAS v4u*)(WUP + (size_t)n * D + 512 * j + 8 * F.lane);
                wf[8 * j + 0] = bf2f(w.x & 0xffff); wf[8 * j + 1] = bf2f(w.x >> 16); wf[8 * j + 2] = bf2f(w.y & 0xffff); wf[8 * j + 3] = bf2f(w.y >> 16);
                wf[8 * j + 4] = bf2f(w.z & 0xffff); wf[8 * j + 5] = bf2f(w.z >> 16); wf[8 * j + 6] = bf2f(w.w & 0xffff); wf[8 * j + 7] = bf2f(w.w >> 16); }
            float mine = 0.f;
            for (int b = 0; b < NBATCH; ++b) {
                const float* s2 = MOD + (size_t)b * 6144 + 3072; float a = 0.f;
#pragma unroll
                for (int j = 0; j < 2; ++j) { const f32x4 p = *(const f32x4*)(s2 + 512 * j + 8 * F.lane), q = *(const f32x4*)(s2 + 512 * j + 8 * F.lane + 4);
                    a += wf[8 * j] * p.x + wf[8 * j + 1] * p.y + wf[8 * j + 2] * p.z + wf[8 * j + 3] * p.w + wf[8 * j + 4] * q.x + wf[8 * j + 5] * q.y + wf[8 * j + 6] * q.z + wf[8 * j + 7] * q.w; }
                a = wave_sum(a);
                if (F.lane == b) mine = a;
            }
            if (F.lane < NBATCH) B2[(size_t)F.lane * DUP + n] = mine;
        }
    }
}

using pg8::Unit;
template <int CTRL> __device__ __forceinline__ float dppf(float x) { return __builtin_bit_cast(float, __builtin_amdgcn_update_dpp(0, __builtin_bit_cast(int, x), CTRL, 0xF, 0xF, false)); }

struct EpiOut {
    static constexpr bool PERM = true, AFTER_DRAIN = false;
    const float* x; float* x1; bf16* a2; const float* mod; const float* n2g; float* ssq;
    __device__ __forceinline__ void operator()(const f32x4 (&acc)[2][2][4][2], const Unit& u, int wr, int wc, int fr, int fq) const {
        const int b = (u.pm * 256) / L, colb = u.pn * 256 + wc * 32 + 8 * fq;
        f32x4 g1v[2][2], gsv[2][2];
#pragma unroll
        for (int bj = 0; bj < 2; ++bj)
#pragma unroll
            for (int n = 0; n < 2; ++n) { const int c = colb + bj * 128 + 4 * n;
                g1v[bj][n] = *(const f32x4*)(mod + (size_t)b * 6144 + 2048 + c);
                gsv[bj][n] = *(const f32x4*)(n2g + c) * (1.f + *(const f32x4*)(mod + (size_t)b * 6144 + 4096 + c)); }
#pragma unroll
        for (int ai = 0; ai < 2; ++ai)
#pragma unroll
            for (int m = 0; m < 4; ++m) {
                const size_t row = (size_t)u.pm * 256 + ai * 128 + wr * 64 + m * 16 + fr; float q = 0.f;
#pragma unroll
                for (int bj = 0; bj < 2; ++bj) {
                    const size_t off = row * D + colb + bj * 128;
                    const f32x4 xa = *(const f32x4*)(x + off), xb = *(const f32x4*)(x + off + 4);
                    const f32x4 v0 = xa + g1v[bj][0] * acc[ai][bj][m][0], v1 = xb + g1v[bj][1] * acc[ai][bj][m][1];
                    *(f32x4*)(x1 + off) = v0; *(f32x4*)(x1 + off + 4) = v1;
                    q += (v0.x * v0.x + v0.y * v0.y) + (v0.z * v0.z + v0.w * v0.w) + (v1.x * v1.x + v1.y * v1.y) + (v1.z * v1.z + v1.w * v1.w);
                    const f32x4 a0 = v0 * gsv[bj][0], a1 = v1 * gsv[bj][1];
                    v4u w; w.x = pg8::cvt_pk_bf16(a0.x, a0.y); w.y = pg8::cvt_pk_bf16(a0.z, a0.w); w.z = pg8::cvt_pk_bf16(a1.x, a1.y); w.w = pg8::cvt_pk_bf16(a1.z, a1.w);
                    *(v4u*)(a2 + off) = w;
                }
                q += __shfl_xor(q, 16); q += __shfl_xor(q, 32);
                if (fq == 0) ssq[row * 16 + u.pn * 4 + wc] = q;
            }
    }
};

struct EpiUp {
    static constexpr bool PERM = true, AFTER_DRAIN = false;
    const float* ssq1; const float* bias2; const float* cw; const float* cb; bf16* hid; float* edge_g; float* edge_u;
    __device__ __forceinline__ void operator()(const f32x4 (&acc)[2][2][4][2], const Unit& u, int wr, int wc, int fr, int fq) const {
        const int b = (u.pm * 256) / L, j = u.pn, cc0 = wc * 32 + 8 * fq;
#pragma unroll
        for (int ai = 0; ai < 2; ++ai) {
            const int row0 = u.pm * 256 + ai * 128 + wr * 64, blk = row0 >> 6;
            float rs[4];
#pragma unroll
            for (int m = 0; m < 4; ++m) { const f32x4 p = *(const f32x4*)(ssq1 + (size_t)(row0 + m * 16 + fr) * 16 + 4 * fq); float s = (p.x + p.y) + (p.z + p.w);
                s += __shfl_xor(s, 16); s += __shfl_xor(s, 32); rs[m] = rsqrtf(s * (1.f / D) + EPS); }
#pragma unroll
            for (int n = 0; n < 2; ++n) {
                const int c = 128 * j + cc0 + 4 * n;
                const f32x4 bg = *(const f32x4*)(bias2 + (size_t)b * DUP + 256 * j + cc0 + 4 * n), bu = *(const f32x4*)(bias2 + (size_t)b * DUP + 256 * j + 128 + cc0 + 4 * n);
                const f32x4 cw0 = *(const f32x4*)(cw + c), cw1 = *(const f32x4*)(cw + DFF + c), cw2 = *(const f32x4*)(cw + 2 * DFF + c), cbv = *(const f32x4*)(cb + c);
                f32x4 Gv[4], Uv[4], Rv[4], Lv[4];
#pragma unroll
                for (int m = 0; m < 4; ++m) { Gv[m] = acc[ai][0][m][n] * rs[m] + bg; Uv[m] = acc[ai][1][m][n] * rs[m] + bu;
#pragma unroll
                    for (int i = 0; i < 4; ++i) { Rv[m][i] = dppf<0x121>(Gv[m][i]); Lv[m][i] = dppf<0x12F>(Gv[m][i]); } }
#pragma unroll
                for (int m = 0; m < 4; ++m) {
                    const f32x4 prev = fr > 0 ? Rv[m] : Rv[m > 0 ? m - 1 : 0], next = fr < 15 ? Lv[m] : Lv[m < 3 ? m + 1 : 3];
                    const f32x4 gt = cw0 * prev + cw1 * Gv[m] + cw2 * next + cbv;
                    f32x4 h; h.x = siluf(gt.x) * Uv[m].x; h.y = siluf(gt.y) * Uv[m].y; h.z = siluf(gt.z) * Uv[m].z; h.w = siluf(gt.w) * Uv[m].w;
                    const bool interior = !((m == 0 && fr == 0) || (m == 3 && fr == 15));
                    if (interior) { v2u w; w.x = pg8::cvt_pk_bf16(h.x, h.y); w.y = pg8::cvt_pk_bf16(h.z, h.w); *(v2u*)(hid + (size_t)(row0 + m * 16 + fr) * DFF + c) = w; }
                }
                if (fr == 0) { *(f32x4*)(edge_g + ((size_t)blk * 4 + 0) * DFF + c) = Gv[0]; *(f32x4*)(edge_u + ((size_t)blk * 2 + 0) * DFF + c) = Uv[0]; }
                if (fr == 1) { *(f32x4*)(edge_g + ((size_t)blk * 4 + 1) * DFF + c) = Gv[0]; }
                if (fr == 14) { *(f32x4*)(edge_g + ((size_t)blk * 4 + 2) * DFF + c) = Gv[3]; }
                if (fr == 15) { *(f32x4*)(edge_g + ((size_t)blk * 4 + 3) * DFF + c) = Gv[3]; *(f32x4*)(edge_u + ((size_t)blk * 2 + 1) * DFF + c) = Uv[3]; }
            }
        }
    }
};

struct EpiDown {
    static constexpr bool PERM = true, AFTER_DRAIN = false;
    float* x1; const float* mod;
    __device__ __forceinline__ void operator()(const f32x4 (&acc)[2][2][4][2], const Unit& u, int wr, int wc, int fr, int fq) const {
        const int b = (u.pm * 256) / L, colb = u.pn * 256 + wc * 32 + 8 * fq;
        f32x4 g2v[2][2];
#pragma unroll
        for (int bj = 0; bj < 2; ++bj)
#pragma unroll
            for (int n = 0; n < 2; ++n) g2v[bj][n] = *(const f32x4*)(mod + (size_t)b * 6144 + 5120 + colb + bj * 128 + 4 * n);
#pragma unroll
        for (int ai = 0; ai < 2; ++ai)
#pragma unroll
            for (int m = 0; m < 4; ++m) {
                const size_t row = (size_t)u.pm * 256 + ai * 128 + wr * 64 + m * 16 + fr;
#pragma unroll
                for (int bj = 0; bj < 2; ++bj) { const size_t off = row * D + colb + bj * 128;
                    const f32x4 xa = *(const f32x4*)(x1 + off), xb = *(const f32x4*)(x1 + off + 4);
                    *(f32x4*)(x1 + off) = xa + g2v[bj][0] * acc[ai][bj][m][0]; *(f32x4*)(x1 + off + 4) = xb + g2v[bj][1] * acc[ai][bj][m][1]; }
            }
    }
};

struct EpiIn {
    static constexpr bool PERM = true, AFTER_DRAIN = false;
    bf16 *qf, *kf, *qb, *kb, *v, *g; float *df, *db; const float* hgrn_lb; const float* ret_decay; const float2* rope;
    static __device__ __forceinline__ v2u pk4(const f32x4 a) { v2u w; w.x = pg8::cvt_pk_bf16(a.x, a.y); w.y = pg8::cvt_pk_bf16(a.z, a.w); return w; }
    static __device__ __forceinline__ v4u pk8(const f32x4 a, const f32x4 b) { v4u w; w.x = pg8::cvt_pk_bf16(a.x, a.y); w.y = pg8::cvt_pk_bf16(a.z, a.w); w.z = pg8::cvt_pk_bf16(b.x, b.y); w.w = pg8::cvt_pk_bf16(b.z, b.w); return w; }
    static __device__ __forceinline__ void scan64(f32x4 (&x)[4], f32x4& tot, int fr) {
        f32x4 run = {0.f, 0.f, 0.f, 0.f};
#pragma unroll
        for (int m = 0; m < 4; ++m) {
#pragma unroll
            for (int i = 0; i < 4; ++i) {
                float s = x[m][i], t = x[m][i];
                float a;
                a = dppf<0x111>(s); s = fr >= 1 ? s + a : s;
                a = dppf<0x112>(s); s = fr >= 2 ? s + a : s;
                a = dppf<0x114>(s); s = fr >= 4 ? s + a : s;
                a = dppf<0x118>(s); s = fr >= 8 ? s + a : s;
                t += dppf<0x128>(t); t += dppf<0x124>(t); t += dppf<0x122>(t); t += dppf<0x121>(t);
                x[m][i] = s + run[i]; run[i] += t;
            }
        }
        tot = run;
    }
    __device__ __forceinline__ void operator()(const f32x4 (&acc)[2][2][4][2], const Unit& u, int wr, int wc, int fr, int fq) const {
        const int tile = u.pn; const bool isctx = u.pm >= 128;
        const int cc0 = wc * 32 + 8 * fq;
        if (tile < 8) {
            const int h = tile >> 1, kh = tile & 1, key0 = 64 * kh + 16 * wc + 4 * fq, hc = h * 128 + key0;
            const f32x4 a0f = *(const f32x4*)(hgrn_lb + 0 * 512 + hc), a1f = *(const f32x4*)(hgrn_lb + 1 * 512 + hc), a0b = *(const f32x4*)(hgrn_lb + 2 * 512 + hc), a1b = *(const f32x4*)(hgrn_lb + 3 * 512 + hc);
            f32x4 lbf, lbb;
#pragma unroll
            for (int i = 0; i < 4; ++i) { lbf[i] = 1.f / (1.f + __expf(a1f[i] - a0f[i])); lbb[i] = 1.f / (1.f + __expf(a1b[i] - a0b[i])); }
#pragma unroll
            for (int ai = 0; ai < 2; ++ai) {
                const size_t row0 = (size_t)u.pm * 256 + ai * 128 + wr * 64;
                {
                    f32x4 lf[4], kk[4], tot;
#pragma unroll
                    for (int m = 0; m < 4; ++m)
#pragma unroll
                        for (int i = 0; i < 4; ++i) { const float sg = sigm(acc[ai][0][m][1][i]); const float f = lbf[i] + (1.f - lbf[i]) * sg; lf[m][i] = __logf(f); kk[m][i] = 1.f - f; }
                    scan64(lf, tot, fr);
#pragma unroll
                    for (int m = 0; m < 4; ++m) { const size_t o = (row0 + m * 16 + fr) * D + hc; f32x4 qv, kv;
#pragma unroll
                        for (int i = 0; i < 4; ++i) { qv[i] = acc[ai][0][m][0][i] * __expf(lf[m][i]); kv[i] = kk[m][i] * __expf(-lf[m][i]); }
                        if (!isctx) *(v2u*)(qf + o) = pk4(qv);
                        *(v2u*)(kf + o) = pk4(kv); *(v2u*)(v + o) = pk4(acc[ai][1][m][1]); }
                    if (fr == 0) { f32x4 d; d.x = __expf(tot.x); d.y = __expf(tot.y); d.z = __expf(tot.z); d.w = __expf(tot.w); *(f32x4*)(df + (row0 >> 6) * 512 + hc) = d; }
                }
                {
                    f32x4 lf[4], lraw[4], kk[4], tot;
#pragma unroll
                    for (int m = 0; m < 4; ++m)
#pragma unroll
                        for (int i = 0; i < 4; ++i) { const float sg = sigm(acc[ai][1][m][0][i]); const float f = lbb[i] + (1.f - lbb[i]) * sg; lf[m][i] = __logf(f); lraw[m][i] = lf[m][i]; kk[m][i] = 1.f - f; }
                    scan64(lf, tot, fr);
#pragma unroll
                    for (int m = 0; m < 4; ++m) { const size_t o = (row0 + m * 16 + fr) * D + hc; f32x4 qv, kv;
#pragma unroll
                        for (int i = 0; i < 4; ++i) { const float bb = tot[i] - lf[m][i] + lraw[m][i]; qv[i] = acc[ai][0][m][0][i] * __expf(bb); kv[i] = kk[m][i] * __expf(-bb); }
                        if (!isctx) *(v2u*)(qb + o) = pk4(qv);
                        *(v2u*)(kb + o) = pk4(kv); }
                    if (fr == 0) { f32x4 d; d.x = __expf(tot.x); d.y = __expf(tot.y); d.z = __expf(tot.z); d.w = __expf(tot.w); *(f32x4*)(db + (row0 >> 6) * 512 + hc) = d; }
                }
            }
        } else if (tile < 10 || tile >= 14) {
            const int kind = tile < 10 ? 0 : (tile < 16 ? 1 : 2);
            const int cbase = (kind == 0 ? 256 * (tile - 8) : (kind == 1 ? 512 + 256 * (tile - 14) : 512 + 256 * (tile - 16))) + cc0;
            bf16* dst = kind == 1 ? v : g;
#pragma unroll
            for (int ai = 0; ai < 2; ++ai)
#pragma unroll
                for (int m = 0; m < 4; ++m) { const size_t row = (size_t)u.pm * 256 + ai * 128 + wr * 64 + m * 16 + fr;
#pragma unroll
                    for (int bj = 0; bj < 2; ++bj) { f32x4 a = acc[ai][bj][m][0], b = acc[ai][bj][m][1];
                        if (kind == 0) { for (int i = 0; i < 4; ++i) { a[i] = sigm(a[i]); b[i] = sigm(b[i]); } }
                        if (kind == 2) { for (int i = 0; i < 4; ++i) { a[i] = siluf(a[i]); b[i] = siluf(b[i]); } }
                        *(v4u*)(dst + row * D + cbase + 128 * bj) = pk8(a, b); } }
        } else {
            const bool isq = tile < 12; const int hbase = 2 * (tile - (isq ? 10 : 12));
            const int half = wc >> 1, i0b = ((cc0 & 63) >> 1);
            float lg[2][2];
#pragma unroll
            for (int bj = 0; bj < 2; ++bj)
#pragma unroll
                for (int d = 0; d < 2; ++d) lg[bj][d] = -log1pf(expf(-ret_decay[d * 4 + hbase + bj]));
            const float sgn = isq ? 1.f : -1.f, scl = isq ? 1.f : 0.08838834764831845f;
#pragma unroll
            for (int ai = 0; ai < 2; ++ai)
#pragma unroll
                for (int m = 0; m < 4; ++m) {
                    const size_t row = (size_t)u.pm * 256 + ai * 128 + wr * 64 + m * 16 + fr; const int ic = m * 16 + fr;
                    f32x4 cs01 = {1.f, 0.f, 1.f, 0.f}, cs23 = {1.f, 0.f, 1.f, 0.f};
                    if (!isctx) { const int pos = half == 0 ? (int)((row & 2047) >> 6) : ic; const float2* rp = rope + pos * 32 + i0b;
                        cs01 = *(const f32x4*)rp; cs23 = *(const f32x4*)(rp + 2); }
#pragma unroll
                    for (int bj = 0; bj < 2; ++bj) {
                        const f32x4 a = acc[ai][bj][m][0] * scl, b = acc[ai][bj][m][1] * scl; f32x4 ra, rb;
                        ra.x = a.x * cs01.x - a.y * cs01.y; ra.y = a.x * cs01.y + a.y * cs01.x; ra.z = a.z * cs01.z - a.w * cs01.w; ra.w = a.z * cs01.w + a.w * cs01.z;
                        rb.x = b.x * cs23.x - b.y * cs23.y; rb.y = b.x * cs23.y + b.y * cs23.x; rb.z = b.z * cs23.z - b.w * cs23.w; rb.w = b.z * cs23.w + b.w * cs23.z;
                        const float ef = __expf(sgn * (float)(ic + 1) * lg[bj][0]), eb = __expf(sgn * (float)(64 - ic) * lg[bj][1]);
                        const size_t o = row * D + 512 + (hbase + bj) * 128 + cc0;
                        if (isq) { *(v4u*)(qf + o) = pk8(ra * ef, rb * ef); *(v4u*)(qb + o) = pk8(ra * eb, rb * eb); }
                        else { *(v4u*)(kf + o) = pk8(ra * ef, rb * ef); *(v4u*)(kb + o) = pk8(ra * eb, rb * eb); }
                    }
                }
        }
    }
};
struct InOrder {
    pg8::StaticOrder so; int G, c;
    __device__ void init(int G_, int c_) { so.init(M, NIN, G_, c_); G = G_; c = c_; }
    __device__ bool next(int i, Unit& u) const {
        const long Li = (long)i * G + c;
        if (Li < 2304) return so.next(i, u);
        const int r = (int)(Li - 2304); if (r >= 192) return false;
        u.pm = 128 + r / 12; const int q = r % 12; u.pn = q < 8 ? q : q + 4; return true;
    }
    __device__ __forceinline__ void a_ready(const Unit&) const {}
    __device__ __forceinline__ void done(const Unit&) const {}
};


__device__ __forceinline__ void edge_phase(Frame& F) {
    const int gw = F.vcu * NWAVES + F.wave, NGW = F.G * NWAVES;
    const float* EG = (const float*)(F.ws + WS_EDGEG); const float* EU = (const float*)(F.ws + WS_EDGEU); bf16* hid = (bf16*)(F.ws + WS_HID);
    for (int it = gw; it < 1024 * 11; it += NGW) {
        const int er = it / 11, q = it % 11, blk = er >> 1, e2 = er & 1, c = 256 * q + 4 * F.lane;
        const int row = 64 * blk + (e2 ? 63 : 0), t = row % L;
        f32x4 prev, cur, next; const f32x4 z = {0.f, 0.f, 0.f, 0.f};
        if (e2 == 0) { prev = t == 0 ? z : *(const f32x4*)(EG + ((size_t)(blk - 1) * 4 + 3) * DFF + c); cur = *(const f32x4*)(EG + ((size_t)blk * 4 + 0) * DFF + c); next = *(const f32x4*)(EG + ((size_t)blk * 4 + 1) * DFF + c); }
        else { prev = *(const f32x4*)(EG + ((size_t)blk * 4 + 2) * DFF + c); cur = *(const f32x4*)(EG + ((size_t)blk * 4 + 3) * DFF + c); next = t == L - 1 ? z : *(const f32x4*)(EG + ((size_t)(blk + 1) * 4 + 0) * DFF + c); }
        const f32x4 up = *(const f32x4*)(EU + ((size_t)blk * 2 + e2) * DFF + c);
        const f32x4 cw0 = *(const f32x4*)(F.conv_w + c), cw1 = *(const f32x4*)(F.conv_w + DFF + c), cw2 = *(const f32x4*)(F.conv_w + 2 * DFF + c), cbv = *(const f32x4*)(F.conv_b + c);
        const f32x4 gt = cw0 * prev + cw1 * cur + cw2 * next + cbv;
        v2u w; w.x = pk2(siluf(gt.x) * up.x, siluf(gt.y) * up.y); w.y = pk2(siluf(gt.z) * up.z, siluf(gt.w) * up.w);
        *(v2u*)(hid + (size_t)row * DFF + c) = w;
    }
}

__device__ __forceinline__ void final_phase(Frame& F) {
    const int gw = F.vcu * NWAVES + F.wave, NGW = F.G * NWAVES;
    const int per = (M + NGW - 1) / NGW, r0 = gw * per, r1 = (r0 + per) < M ? (r0 + per) : M;
    f32x4 g[4];
#pragma unroll
    for (int j = 0; j < 4; ++j) g[j] = *(const f32x4*)(F.final_g + 4 * F.lane + 256 * j);
    for (int m = r0; m < r1; ++m) {
        GAS f32x4* xr = (GAS f32x4*)(F.out + (size_t)m * D) + F.lane;
        f32x4 v[4]; float s = 0.f;
#pragma unroll
        for (int j = 0; j < 4; ++j) { v[j] = xr[64 * j]; s += (v[j].x * v[j].x + v[j].y * v[j].y) + (v[j].z * v[j].z + v[j].w * v[j].w); }
        const float rstd = rsqrtf(wave_sum(s) * (1.f / D) + EPS);
#pragma unroll
        for (int j = 0; j < 4; ++j) xr[64 * j] = v[j] * rstd * g[j];
    }
}

namespace mx {
typedef float f32x16 __attribute__((ext_vector_type(16)));
typedef float f32x8 __attribute__((ext_vector_type(8)));
typedef __bf16 bf8 __attribute__((ext_vector_type(8)));
typedef short s16x4 __attribute__((ext_vector_type(4)));
typedef short s16x8 __attribute__((ext_vector_type(8)));
#define MX_MFMA(a, b, c) __builtin_amdgcn_mfma_f32_32x32x16_bf16((a), (b), (c), 0, 0, 0)
constexpr int IMG = 16384, BUFB = 3 * IMG, OST_OFF = 2 * BUFB, DVEC_OFF = 132096;
__device__ __forceinline__ unsigned off_b(unsigned row, unsigned ch) { return 256u * row + 16u * (ch ^ (((row & 3u) << 2) | ((row >> 2) & 3u))); }
__device__ __forceinline__ int crow(int reg, int h) { return (reg & 3) + 8 * (reg >> 2) + 4 * h; }
__device__ __forceinline__ s16x8 pack_step(const f32x16& x, int s) { f32x8 t;
#pragma unroll
    for (int i = 0; i < 8; ++i) t[i] = x[8 * s + i];
    return __builtin_bit_cast(s16x8, __builtin_convertvector(t, bf8)); }
__device__ __forceinline__ s16x8 row_read(LAS unsigned char* img, unsigned row, unsigned ch) { return *(LAS s16x8*)(img + off_b(row, ch)); }
__device__ __forceinline__ s16x4 tr4(LAS unsigned char* p) { return __builtin_amdgcn_ds_read_tr16_b64_v4i16((LAS s16x4*)p); }
__device__ __forceinline__ s16x8 cat8(s16x4 lo, s16x4 hi) { return __builtin_shufflevector(lo, hi, 0, 1, 2, 3, 4, 5, 6, 7); }

__device__ __forceinline__ void stage_chunk(LAS unsigned char* buf, const bf16* q, const bf16* k, const bf16* v, size_t row0, int col0, int narr, int wave, int lane) {
    const int per = narr * 2;
    for (int qi = 0; qi < per; ++qi) {
        const int idx = wave * per + qi, a = idx >> 4, i = idx & 15, arr = a + (3 - narr);
        const bf16* base = arr == 0 ? q : (arr == 1 ? k : v);
        const unsigned rl = 4 * i + (lane >> 4), pos = lane & 15, ch = pos ^ (((rl & 3u) << 2) | ((rl >> 2) & 3u));
        const bf16* src = base + (row0 + rl) * (size_t)D + col0 + 8 * ch;
        __builtin_amdgcn_global_load_lds((const unsigned*)src, (LAS unsigned*)(buf + arr * IMG + i * 1024), 16, 0, 0);
    }
}

template <bool FWD>
__device__ __forceinline__ void chunk_compute(LAS unsigned char* buf, LAS unsigned char* ost, const LAS float* dvec, f32x16 (&S)[4], bool with_out, int w, int lane) {
    asm volatile("" : "+v"(lane));
    LAS unsigned char* qimg = buf; LAS unsigned char* kimg = buf + IMG; LAS unsigned char* vimg = buf + 2 * IMG;
    const unsigned r = lane & 31, h = lane >> 5, blk = (lane >> 4) & 1, q4 = (lane & 15) >> 2, p = lane & 3;
    if (with_out) {
        f32x16 o[2];
#pragma unroll
        for (int i = 0; i < 16; ++i) { o[0][i] = 0.f; o[1][i] = 0.f; }
#pragma unroll
        for (int kb = 0; kb < 4; ++kb)
#pragma unroll
            for (int st = 0; st < 2; ++st) {
                const s16x8 xs = pack_step(S[kb], st);
#pragma unroll
                for (int tt = 0; tt < 2; ++tt) {
                    const unsigned row = 32 * tt + r, ch0 = 4 * kb + 2 * st;
                    const s16x4 lo = *(LAS s16x4*)(qimg + off_b(row, ch0) + 8 * h), hi = *(LAS s16x4*)(qimg + off_b(row, ch0 + 1) + 8 * h);
                    o[tt] = MX_MFMA(cat8(lo, hi), xs, o[tt]);
                }
            }
#pragma unroll
        for (int tile = 0; tile < 3; ++tile) {
            const int st = FWD ? (tile == 2 ? 1 : 0) : (tile == 0 ? 0 : 1), tt = FWD ? (tile == 0 ? 0 : 1) : (tile == 2 ? 1 : 0);
            f32x16 X;
#pragma unroll
            for (int i = 0; i < 16; ++i) X[i] = 0.f;
#pragma unroll
            for (int ks = 0; ks < 8; ++ks) X = MX_MFMA(row_read(kimg, 32 * st + r, 2 * ks + h), row_read(qimg, 32 * tt + r, 2 * ks + h), X);
            if (st == tt) {
#pragma unroll
                for (int i = 0; i < 16; ++i) { const int sl = crow(i, h); const bool keep = FWD ? ((int)r >= sl) : ((int)r <= sl); X[i] = keep ? X[i] : 0.f; }
            }
#pragma unroll
            for (int sp = 0; sp < 2; ++sp) {
                const s16x8 xs = pack_step(X, sp);
                const unsigned R0 = 32 * st + 16 * sp + 4 * h + q4, chv = 4 * w + 2 * blk + (p >> 1);
                const s16x4 lo = tr4(vimg + off_b(R0, chv) + 8 * (p & 1)), hi = tr4(vimg + off_b(R0 + 8, chv) + 8 * (p & 1));
                o[tt] = MX_MFMA(xs, cat8(lo, hi), o[tt]);
            }
        }
#pragma unroll
        for (int tt = 0; tt < 2; ++tt)
#pragma unroll
            for (int i = 0; i < 16; ++i) { const unsigned t = 32 * tt + crow(i, h), v = 32 * w + r;
                *(LAS float*)(ost + t * 512 + (((v >> 2) ^ (8u * (t & 1u))) * 16u) + (v & 3u) * 4u) = o[tt][i]; }
    }
#pragma unroll
    for (int ks = 0; ks < 4; ++ks) {
        const unsigned R0 = 16 * ks + 8 * h + q4, chv = 4 * w + 2 * blk + (p >> 1);
        const s16x8 bfrag = cat8(tr4(vimg + off_b(R0, chv) + 8 * (p & 1)), tr4(vimg + off_b(R0 + 4, chv) + 8 * (p & 1)));
#pragma unroll
        for (int kb = 0; kb < 4; ++kb) {
            const unsigned chk = 4 * kb + 2 * blk + (p >> 1);
            const s16x8 afrag = cat8(tr4(kimg + off_b(R0, chk) + 8 * (p & 1)), tr4(kimg + off_b(R0 + 4, chk) + 8 * (p & 1)));
            S[kb] = MX_MFMA(afrag, bfrag, S[kb]);
        }
    }
#pragma unroll
    for (int kb = 0; kb < 4; ++kb)
#pragma unroll
        for (int g = 0; g < 4; ++g) { const f32x4 dv = *(const LAS f32x4*)(dvec + 32 * kb + 8 * g + 4 * h);
            S[kb][4 * g + 0] *= dv.x; S[kb][4 * g + 1] *= dv.y; S[kb][4 * g + 2] *= dv.z; S[kb][4 * g + 3] *= dv.w; }
}

__device__ __forceinline__ size_t chunk_row0(int s, int b, int dir) { return s < 4 ? (size_t)M + (size_t)b * CL + 64 * (dir == 0 ? s : 3 - s) : (size_t)b * L + 64 * (dir == 0 ? s - 4 : 31 - (s - 4)); }
__device__ __forceinline__ void load_dvec(LAS float* dv0, int s, size_t r0, bool isret, float gam64, const float* darr, int hh, int wave, int lane) {
    if (wave == 4) { LAS float* dst = dv0 + (s & 1) * 128;
        if (isret) { dst[lane] = gam64; dst[lane + 64] = gam64; }
        else { const float* src = darr + (r0 >> 6) * 512 + hh * 128; dst[lane] = src[lane]; dst[lane + 64] = src[lane + 64]; } }
}
struct MixIO { const bf16 *qf, *kf, *qb, *kb, *v; bf16* gmix; const float *df, *db; float* ex; };

__device__ __forceinline__ void mixer_phase(Frame& F, const MixIO& io, const XcdBarrier& gbar) {
    const int scan = F.vcu, dir = scan & 1, head = (scan >> 1) & 7, b = scan >> 4;
    const bool isret = head >= 4; const int hh = head & 3, col0 = head * 128;
    LAS unsigned char* lds = F.lds; LAS unsigned char* ost = lds + OST_OFF; LAS float* dv0 = (LAS float*)(lds + DVEC_OFF);
    const bf16* qarr = dir == 0 ? io.qf : io.qb; const bf16* karr = dir == 0 ? io.kf : io.kb; const float* darr = dir == 0 ? io.df : io.db;
    const float gam64 = isret ? expf(-64.f * log1pf(expf(-F.ret_decay[dir * 4 + hh]))) : 0.f;
    f32x16 S[4];
#pragma unroll
    for (int kb = 0; kb < 4; ++kb)
#pragma unroll
        for (int i = 0; i < 16; ++i) S[kb][i] = 0.f;
    const float* gnp = (isret ? F.ret_norm_g : F.hgrn_norm_g) + hh * 128;
    stage_chunk(lds, qarr, karr, io.v, chunk_row0(0, b, dir), col0, 2, F.wave, F.lane);
    load_dvec(dv0, 0, chunk_row0(0, b, dir), isret, gam64, darr, hh, F.wave, F.lane);
    for (int s = 0; s < 36; ++s) {
        if (s == 20) xcd_barrier(gbar);
        const bool isx = s >= 4; const size_t r0 = chunk_row0(s, b, dir);
        VM_WAIT(); LDS_WAIT(); __builtin_amdgcn_s_barrier(); asm volatile("" ::: "memory");
        if (s + 1 < 36) { const size_t rn = chunk_row0(s + 1, b, dir); stage_chunk(lds + ((s + 1) & 1) * BUFB, qarr, karr, io.v, rn, col0, (s + 1) >= 4 ? 3 : 2, F.wave, F.lane); load_dvec(dv0, s + 1, rn, isret, gam64, darr, hh, F.wave, F.lane); }
        if (F.wave < 4) {
            if (dir == 0) chunk_compute<true>(lds + (s & 1) * BUFB, ost, dv0 + (s & 1) * 128, S, isx, F.wave, F.lane);
            else chunk_compute<false>(lds + (s & 1) * BUFB, ost, dv0 + (s & 1) * 128, S, isx, F.wave, F.lane);
        }
        LDS_WAIT(); __builtin_amdgcn_s_barrier(); asm volatile("" ::: "memory");
        if (isx) {
            int tidl = F.tid; asm volatile("" : "+v"(tidl));
            const int prow = tidl >> 3, sub = tidl & 7;
            f32x4 o4[4];
#pragma unroll
            for (int i = 0; i < 4; ++i) o4[i] = *(const LAS f32x4*)(ost + prow * 512 + (((sub + 8 * i) ^ (8 * (prow & 1))) * 16));
            const size_t grow = r0 + prow;
            if (s < 20) {
#pragma unroll
                for (int i = 0; i < 4; ++i) *(f32x4*)(io.ex + grow * D + col0 + 4 * (sub + 8 * i)) = o4[i];
            } else {
                f32x4 gt[4]; float ssq = 0.f;
#pragma unroll
                for (int i = 0; i < 4; ++i) { const size_t off = grow * D + col0 + 4 * (sub + 8 * i);
                    const f32x4 other = *(const f32x4*)(io.ex + off); const v2u gw = *(const v2u*)(io.gmix + off);
                    gt[i] = (f32x4){bf2f(gw.x & 0xffff), bf2f(gw.x >> 16), bf2f(gw.y & 0xffff), bf2f(gw.y >> 16)};
                    o4[i] = o4[i] + other; if (!isret) o4[i] = o4[i] * gt[i];
                    ssq += (o4[i].x * o4[i].x + o4[i].y * o4[i].y) + (o4[i].z * o4[i].z + o4[i].w * o4[i].w); }
                ssq += __shfl_xor(ssq, 1); ssq += __shfl_xor(ssq, 2); ssq += __shfl_xor(ssq, 4);
                const float rstd = rsqrtf(ssq * (1.f / 128.f) + EPS);
#pragma unroll
                for (int i = 0; i < 4; ++i) { f32x4 y = o4[i] * rstd * *(const f32x4*)(gnp + 4 * (sub + 8 * i)); if (isret) y = y * gt[i];
                    v2u w; w.x = pk2(y.x, y.y); w.y = pk2(y.z, y.w); *(v2u*)(io.gmix + grow * D + col0 + 4 * (sub + 8 * i)) = w; }
            }
        }
    }
}
}


struct Args { const float* in[19]; float* out; unsigned char* ws; int ph_lo, ph_hi, li, pad; };
__global__ void __launch_bounds__(NWAVES * 64, 2) mk_fwd(Args args) {
    extern __shared__ __attribute__((aligned(16))) unsigned char lds[];
    Frame F;
    F.lds = (LAS unsigned char*)lds;
    F.MISC = (volatile LAS unsigned*)(F.lds + MISC_OFF);
    F.tid = threadIdx.x; F.lane = F.tid & 63; F.wave = __builtin_amdgcn_readfirstlane(F.tid >> 6);
    F.G = gridDim.x; { const int bx = blockIdx.x; F.vcu = (F.G % 8 == 0) ? (bx % 8) * (F.G / 8) + bx / 8 : bx; }
    F.ws = args.ws; F.ctl = (gu32*)(args.ws + WS_CTL);
    F.x = args.in[0]; F.c = args.in[1]; F.ctx = args.in[2]; F.c_ctx = args.in[3]; F.w_mod = args.in[4]; F.b_mod = args.in[5]; F.norm1_g = args.in[6]; F.w_in = args.in[7];
    F.hgrn_lb = args.in[8]; F.hgrn_norm_g = args.in[9]; F.ret_decay = args.in[10]; F.ret_norm_g = args.in[11]; F.w_out = args.in[12]; F.norm2_g = args.in[13]; F.w_up = args.in[14];
    F.conv_w = args.in[15]; F.conv_b = args.in[16]; F.w_down = args.in[17]; F.final_g = args.in[18]; F.out = args.out;
    for (int u = F.tid; u < (LDS_BYTES - LDSCTL_OFF) / 4; u += NWAVES * 64) ((LAS unsigned*)(F.lds + LDSCTL_OFF))[u] = 0u;
    __syncthreads();
    XcdBarrier bar = xcd_barrier_post((unsigned*)(F.ctl + CW_BAR) + args.li * XCD_BAR_WORDS, F.MISC + 8);
    const int lo = args.ph_lo, hi = args.ph_hi;
#define IN(k) (lo <= (k) && (k) < hi)
#define BOTH(k) (IN(k) && IN((k) + 1))
    const float* MOD = (const float*)(F.ws + WS_MOD);

    if (IN(0)) { p0_prologue(F); if (BOTH(0)) xcd_barrier(bar); }
    if (IN(1)) { p0b_phase(F, (bf16*)F.out); if (BOTH(1)) xcd_barrier(bar); }
    if (IN(2)) {
        pg8::Gemm g{(const pg8::bf16_t*)F.out, (const pg8::bf16_t*)(F.ws + WS_WIN), MT, NIN, D}; InOrder S; S.init(F.G, (int)blockIdx.x);
        EpiIn E{(bf16*)(F.ws + WS_QF), (bf16*)(F.ws + WS_KF), (bf16*)(F.ws + WS_QB), (bf16*)(F.ws + WS_KB), (bf16*)(F.ws + WS_V), (bf16*)(F.ws + WS_G), (float*)(F.ws + WS_DF), (float*)(F.ws + WS_DB),
                F.hgrn_lb, F.ret_decay, (const float2*)(F.ws + WS_ROPE)};
        pg8::gemm_phase<EpiIn, InOrder, true, true>(F.lds + RING_OFF, g, S, E);
        if (BOTH(2)) xcd_barrier(bar);
    }
    if (IN(3)) {
        mx::MixIO io{(const bf16*)(F.ws + WS_QF), (const bf16*)(F.ws + WS_KF), (const bf16*)(F.ws + WS_QB), (const bf16*)(F.ws + WS_KB), (const bf16*)(F.ws + WS_V), (bf16*)(F.ws + WS_G),
                     (const float*)(F.ws + WS_DF), (const float*)(F.ws + WS_DB), F.out};
        mx::mixer_phase(F, io, bar);
        if (IN(5)) xcd_barrier(bar);
    }
    if (IN(5)) {
        pg8::Gemm g{(const pg8::bf16_t*)(F.ws + WS_MIXED), (const pg8::bf16_t*)(F.ws + WS_WOUT), M, D, D}; pg8::StaticOrder S; S.init(M, D, F.G, (int)blockIdx.x);
        EpiOut E{F.x, F.out, (bf16*)(F.ws + WS_A2), MOD, F.norm2_g, (float*)(F.ws + WS_SSQ1)};
        pg8::gemm_phase<EpiOut, pg8::StaticOrder, true, true>(F.lds + RING_OFF, g, S, E);
        if (BOTH(5)) xcd_barrier(bar);
    }
    if (IN(6)) {
        pg8::Gemm g{(const pg8::bf16_t*)(F.ws + WS_A2), (const pg8::bf16_t*)(F.ws + WS_WUP), M, DUP, D}; pg8::StaticOrder S; S.init(M, DUP, F.G, (int)blockIdx.x);
        EpiUp E{(const float*)(F.ws + WS_SSQ1), (const float*)(F.ws + WS_BIAS2), F.conv_w, F.conv_b, (bf16*)(F.ws + WS_HID), (float*)(F.ws + WS_EDGEG), (float*)(F.ws + WS_EDGEU)};
        pg8::gemm_phase<EpiUp, pg8::StaticOrder, true, true>(F.lds + RING_OFF, g, S, E);
        if (BOTH(6)) xcd_barrier(bar);
    }
    if (IN(7)) { edge_phase(F); if (BOTH(7)) xcd_barrier(bar); }
    if (IN(8)) {
        pg8::Gemm g{(const pg8::bf16_t*)(F.ws + WS_HID), (const pg8::bf16_t*)(F.ws + WS_WDN), M, D, DFF}; pg8::StaticOrder S; S.init(M, D, F.G, (int)blockIdx.x);
        EpiDown E{F.out, MOD};
        pg8::gemm_phase<EpiDown, pg8::StaticOrder, true, true>(F.lds + RING_OFF, g, S, E);
        if (BOTH(8)) xcd_barrier(bar);
    }
    if (IN(9)) { final_phase(F); }
#undef IN
#undef BOTH
}


static int mk_grid() {
    static int grid = 0;
    if (grid == 0) {
        int dev = 0, cus = 0, per_cu = 0;
        if (hipGetDevice(&dev) != hipSuccess || hipDeviceGetAttribute(&cus, hipDeviceAttributeMultiprocessorCount, dev) != hipSuccess) { fprintf(stderr, "kernel_launch: device query failed\n"); grid = -1; return grid; }
        if (hipFuncSetAttribute((const void*)mk_fwd, hipFuncAttributeMaxDynamicSharedMemorySize, LDS_BYTES) != hipSuccess) { fprintf(stderr, "kernel_launch: hipFuncSetAttribute failed\n"); grid = -1; return grid; }
        if (hipOccupancyMaxActiveBlocksPerMultiprocessor(&per_cu, (const void*)mk_fwd, NWAVES * 64, LDS_BYTES) != hipSuccess || per_cu < 1) { fprintf(stderr, "kernel_launch: occupancy query reports %d blocks per CU\n", per_cu); (void)hipGetLastError(); grid = -1; return grid; }
        grid = cus;
    }
    return grid;
}
static void mk_launch(const Args& a0, int lo, int hi, int li, int grid, hipStream_t stream) {
    Args a = a0; a.ph_lo = lo; a.ph_hi = hi; a.li = li; a.pad = 0;
    hipLaunchKernelGGL(mk_fwd, dim3(grid), dim3(NWAVES * 64), LDS_BYTES, stream, a);
}
extern "C" void kernel_launch(void* const* d_in, const int* in_sizes, int n_in, void* d_out, int out_size, void* d_ws, size_t ws_size, hipStream_t stream) {
    const int grid = mk_grid(); if (grid < 0) return;
    if (n_in != 19 || out_size != M * D || ws_size < WS_END) { fprintf(stderr, "kernel_launch: unexpected shapes\n"); return; }
    (void)hipMemsetAsync((char*)d_ws + WS_CTL, 0, CTL_ZERO_BYTES, stream);
    Args a{}; for (int i = 0; i < 19; ++i) a.in[i] = (const float*)d_in[i]; a.out = (float*)d_out; a.ws = (unsigned char*)d_ws;
    mk_launch(a, 0, 10, 0, grid, stream);
}
```

```cpp
#include <hip/hip_runtime.h>
#include <cstdio>
#include <cstdint>
#ifndef EXP_TA
#define EXP_TA -1
#endif
#ifndef EXP_TB
#define EXP_TB -1
#endif
#ifndef EXP_TPH
#define EXP_TPH -1
#endif
#define PG8_STAMP(i) do { if (EXP_TA >= 60 && Epi::STAMP_PH == EXP_TPH && ((i) == EXP_TA || (i) == EXP_TB) && blockIdx.x == 0 && tid == 0) ((volatile PG8_LAS unsigned*)(lds + (163840 - 1024 + 320) + 64))[(i) == EXP_TB ? 1 : 0] = (unsigned)__builtin_amdgcn_s_memrealtime(); } while (0)
namespace pg8 {
#define PG8_LAS __attribute__((address_space(3)))
typedef unsigned short bf16_t;
typedef short bf16x8 __attribute__((ext_vector_type(8)));
typedef float f32x4 __attribute__((ext_vector_type(4)));
typedef unsigned u32x4 __attribute__((ext_vector_type(4)));
constexpr int BM = 256, BK = 64, HALF = 128, HTB = HALF * BK * 2  , STAGE_BYTES = 8 * HTB, NXCD = 8, WGM = 8;

__host__ __device__ __forceinline__ int lds_byte(int r, int c) { const int st = (r >> 4) * 2 + (c >> 5), rr = r & 15, cc = c & 31, ob = rr * 64 + cc * 2; return st * 1024 + (ob ^ (((ob >> 9) & 1) << 5)); }
__host__ __device__ __forceinline__ void stage_rc(int b, int& R, int& C) { const int st = b / 1024, sb = b % 1024, swz = sb ^ (((sb >> 9) & 1) << 5); R = (st >> 1) * 16 + swz / 64; C = (st & 1) * 32 + (swz % 64) / 2; }
__host__ __device__ __forceinline__ int aperm64(int p) { return 4 * (p & 15) + (p >> 4); }
__host__ __device__ __forceinline__ int perm32(int rho) { const int n = rho >> 4, i = rho & 15; return 8 * (i >> 2) + 4 * n + (i & 3); }

struct Unit { int pm, pn; };
struct Gemm { const bf16_t* A; const bf16_t* Bt; int M, N, K; };

struct StaticOrder {
    int nM, nN, nwg, G, c;
    __host__ __device__ void init(int M, int N, int G_, int c_) { nM = M / BM; nN = N / BM; nwg = nM * nN; G = G_; c = c_; }
    __host__ __device__ bool next(int i, Unit& u) const {
        const long L = (long)i * G + c; if (L >= nwg) return false;
        int wgid = (int)L; { const int q = nwg / NXCD, r = nwg % NXCD, xcd = wgid % NXCD, off = wgid / NXCD; wgid = (xcd < r ? xcd * (q + 1) : r * (q + 1) + (xcd - r) * q) + off; }
        const int nig = WGM * nN, gid = wgid / nig, fm = gid * WGM, gsz = (nM - fm) < WGM ? (nM - fm) : WGM;
        u.pm = fm + ((wgid % nig) % gsz); u.pn = (wgid % nig) / gsz; return true;
    }
    __device__ __forceinline__ void a_ready(const Unit&) const {}
    __device__ __forceinline__ void done(const Unit&) const {}
};

__device__ __forceinline__ unsigned cvt_pk_bf16(float lo, float hi) { unsigned r; asm volatile("v_cvt_pk_bf16_f32 %0, %1, %2" : "=v"(r) : "v"(lo), "v"(hi)); return r; }

template <class Epi, class Sched, bool ALIGN_EPI = false, bool SP2 = false>
__device__ __forceinline__ void gemm_phase(PG8_LAS unsigned char* lds, const Gemm g, const Sched& S, const Epi& E, const int wave_in) {
    int lane_raw_ = (int)__builtin_amdgcn_mbcnt_hi(~0u, __builtin_amdgcn_mbcnt_lo(~0u, 0u)); asm volatile("" : "+v"(lane_raw_));
    const int lane = lane_raw_, wid = wave_in, tid = wid * 64 + lane, wr = wid >> 2, wc = wid & 3, fr = lane & 15, fq = lane >> 4;
    const int K = g.K, nt = K / BK;
    unsigned voffA[2], voffB[2];
#pragma unroll
    for (int i = 0; i < 2; ++i) { int R, C; stage_rc(tid * 16 + i * 8192, R, C); const int Rb = Epi::PERM ? ((R & ~31) + perm32(R & 31)) : R;
        const int Ra = Epi::APERM ? ((R & ~63) + aperm64(R & 63)) : R;
        voffA[i] = (unsigned)(Ra * K + C) * 2u; voffB[i] = (unsigned)(Rb * K + C) * 2u; }
    const size_t kstep = (size_t)(BK * 2);
    const size_t hstep = (size_t)HALF * K * 2;
    const size_t tstep = 2 * hstep;
    const unsigned ldsw = (unsigned)wid * 1024u;
    const int aoff = lds_byte(wr * 64 + fr, fq * 8), boff = lds_byte(wc * 32 + fr, fq * 8);
#define PG8_SA(b, h) (((b) * 2 + (h)) * HTB)
#define PG8_SB(b, h) ((4 + (b) * 2 + (h)) * HTB)
#define PG8_STAGE(bufoff, gbase, voff) do { _Pragma("unroll") for (int _i = 0; _i < 2; ++_i) \
        __builtin_amdgcn_global_load_lds((const unsigned*)((const char*)(gbase) + (voff)[_i]), (PG8_LAS unsigned*)(lds + (bufoff) + ldsw + _i * 8192), 16, 0, 0); } while (0)
#define PG8_LDA(dst, b, h) do { _Pragma("unroll") for (int m = 0; m < 4; ++m) _Pragma("unroll") for (int k = 0; k < 2; ++k) dst[m][k] = *(const PG8_LAS bf16x8*)(lds + PG8_SA(b, h) + aoff + m * 2048 + k * 1024); } while (0)
#define PG8_LDB(dst, b, h) do { _Pragma("unroll") for (int n = 0; n < 2; ++n) _Pragma("unroll") for (int k = 0; k < 2; ++k) dst[n][k] = *(const PG8_LAS bf16x8*)(lds + PG8_SB(b, h) + boff + n * 2048 + k * 1024); } while (0)
#define PG8_MMA(ai, bj, At, Bt) do { __builtin_amdgcn_s_setprio(1); _Pragma("unroll") for (int m = 0; m < 4; ++m) _Pragma("unroll") for (int n = 0; n < 2; ++n) _Pragma("unroll") for (int k = 0; k < 2; ++k) \
        acc[ai][bj][m][n] = __builtin_amdgcn_mfma_f32_16x16x32_bf16(Bt[n][k], At[m][k], acc[ai][bj][m][n], 0, 0, 0); __builtin_amdgcn_s_setprio(0); } while (0)
#define PG8_WAIT_V(n) asm volatile("s_waitcnt vmcnt(" #n ")" ::: "memory")
#define PG8_WAIT_L(n) asm volatile("s_waitcnt lgkmcnt(" #n ")" ::: "memory")
#define PG8_BAR __builtin_amdgcn_s_barrier()
#define PG8_SCHED __builtin_amdgcn_sched_barrier(0)
    Unit cur, nxt; int ui = 0;
    if (!S.next(0, cur)) return;
    f32x4 acc[2][2][4][2];
#pragma unroll
    for (int a = 0; a < 2; ++a)
#pragma unroll
        for (int b = 0; b < 2; ++b)
#pragma unroll
            for (int m = 0; m < 4; ++m)
#pragma unroll
                for (int n = 0; n < 2; ++n) acc[a][b][m][n] = (f32x4){0.f, 0.f, 0.f, 0.f};
    bf16x8 At[4][2], B0[2][2], B1[2][2];
    const char* cA = (const char*)g.A + (size_t)cur.pm * tstep; const char* cB = (const char*)g.Bt + (size_t)cur.pn * tstep;
    S.a_ready(cur);
    if constexpr (SP2) {
        PG8_STAGE(PG8_SB(0, 0), cB, voffB); PG8_STAGE(PG8_SB(0, 1), cB + hstep, voffB); PG8_STAGE(PG8_SA(0, 0), cA, voffA); PG8_STAGE(PG8_SA(0, 1), cA + hstep, voffA);
        if (wr == 1) PG8_BAR;
        PG8_WAIT_V(2); PG8_BAR;
        PG8_STAGE(PG8_SB(1, 0), cB + kstep, voffB); PG8_STAGE(PG8_SA(1, 0), cA + kstep, voffA); PG8_STAGE(PG8_SB(1, 1), cB + hstep + kstep, voffB);
        PG8_WAIT_V(6); PG8_BAR;
    } else {
        PG8_STAGE(PG8_SB(0, 0), cB, voffB); PG8_STAGE(PG8_SA(0, 0), cA, voffA); PG8_STAGE(PG8_SB(0, 1), cB + hstep, voffB); PG8_STAGE(PG8_SA(0, 1), cA + hstep, voffA);
        if (wr == 1) PG8_BAR;
        PG8_WAIT_V(4); PG8_BAR;
        PG8_STAGE(PG8_SB(1, 0), cB + kstep, voffB); PG8_STAGE(PG8_SA(1, 0), cA + kstep, voffA); PG8_STAGE(PG8_SB(1, 1), cB + hstep + kstep, voffB);
        PG8_WAIT_V(6); PG8_BAR;
    }
    for (;;) {
        const bool has_next = S.next(ui + 1, nxt);
        const char* nA = has_next ? (const char*)g.A + (size_t)nxt.pm * tstep : cA; const char* nB = has_next ? (const char*)g.Bt + (size_t)nxt.pn * tstep : cB;
        for (int t = 0; t < nt; t += 2) {
            const bool last = (t == nt - 2);
            const char* a1 = cA + (size_t)(t + 1) * kstep;
            const char* a2 = last ? nA : cA + (size_t)(t + 2) * kstep; const char* b2 = last ? nB : cB + (size_t)(t + 2) * kstep;
            const char* a3 = a2 + kstep; const char* b3 = b2 + kstep;
            if (last && has_next) S.a_ready(nxt);
            if constexpr (SP2) {
            PG8_LDB(B0, 0, 0); PG8_LDB(B1, 0, 1); PG8_SCHED; PG8_LDA(At, 0, 0); PG8_STAGE(PG8_SA(1, 1), a1 + hstep, voffA);
            PG8_WAIT_V(8); PG8_WAIT_L(0); PG8_BAR; PG8_MMA(0, 0, At, B0); PG8_MMA(0, 1, At, B1); PG8_BAR; PG8_SCHED;
            PG8_LDA(At, 0, 1); PG8_STAGE(PG8_SB(0, 0), b2, voffB); PG8_STAGE(PG8_SB(0, 1), b2 + hstep, voffB); PG8_STAGE(PG8_SA(0, 0), a2, voffA);
            PG8_WAIT_V(8); PG8_WAIT_L(0); PG8_BAR; PG8_MMA(1, 0, At, B0); PG8_MMA(1, 1, At, B1); PG8_BAR; PG8_SCHED;
            PG8_LDB(B0, 1, 0); PG8_LDB(B1, 1, 1); PG8_SCHED; PG8_LDA(At, 1, 0); PG8_STAGE(PG8_SA(0, 1), a2 + hstep, voffA);
            PG8_WAIT_V(8); PG8_WAIT_L(0); PG8_BAR; PG8_MMA(0, 0, At, B0); PG8_MMA(0, 1, At, B1); PG8_BAR; PG8_SCHED;
            PG8_LDA(At, 1, 1); PG8_STAGE(PG8_SB(1, 0), b3, voffB); PG8_STAGE(PG8_SB(1, 1), b3 + hstep, voffB); PG8_STAGE(PG8_SA(1, 0), a3, voffA);
            PG8_WAIT_V(8); PG8_WAIT_L(0); PG8_BAR; PG8_MMA(1, 0, At, B0); PG8_MMA(1, 1, At, B1); PG8_BAR; PG8_SCHED;
            } else {
            PG8_LDB(B0, 0, 0); PG8_SCHED; PG8_LDA(At, 0, 0); PG8_STAGE(PG8_SA(1, 1), a1 + hstep, voffA);
            PG8_WAIT_L(8); PG8_BAR; PG8_WAIT_L(0); PG8_MMA(0, 0, At, B0); PG8_BAR; PG8_SCHED;
            PG8_LDB(B1, 0, 1); PG8_STAGE(PG8_SB(0, 0), b2, voffB);
            PG8_BAR; PG8_WAIT_L(0); PG8_MMA(0, 1, At, B1); PG8_BAR;
            PG8_LDA(At, 0, 1); PG8_STAGE(PG8_SA(0, 0), a2, voffA);
            PG8_BAR; PG8_WAIT_L(0); PG8_MMA(1, 0, At, B0); PG8_BAR; PG8_SCHED;
            PG8_STAGE(PG8_SB(0, 1), b2 + hstep, voffB);
            PG8_WAIT_V(6); PG8_BAR; PG8_MMA(1, 1, At, B1); PG8_BAR;
            PG8_LDB(B0, 1, 0); PG8_SCHED; PG8_LDA(At, 1, 0); PG8_STAGE(PG8_SA(0, 1), a2 + hstep, voffA);
            PG8_WAIT_L(8); PG8_BAR; PG8_WAIT_L(0); PG8_MMA(0, 0, At, B0); PG8_BAR; PG8_SCHED;
            PG8_LDB(B1, 1, 1); PG8_STAGE(PG8_SB(1, 0), b3, voffB);
            PG8_BAR; PG8_WAIT_L(0); PG8_MMA(0, 1, At, B1); PG8_BAR;
            PG8_LDA(At, 1, 1); PG8_STAGE(PG8_SA(1, 0), a3, voffA);
            PG8_BAR; PG8_WAIT_L(0); PG8_MMA(1, 0, At, B0); PG8_BAR; PG8_SCHED;
            PG8_STAGE(PG8_SB(1, 1), b3 + hstep, voffB);
            PG8_WAIT_V(6); PG8_BAR; PG8_MMA(1, 1, At, B1); PG8_BAR;
            }
        }
        if constexpr (ALIGN_EPI) { if (wr == 0) PG8_BAR; }
        PG8_STAMP(60 + 2 * ui);
        if constexpr (!Epi::AFTER_DRAIN) { E(acc, cur, wr, wc, fr, fq); S.done(cur); }
        PG8_STAMP(61 + 2 * ui);
        if (!has_next) break;
#pragma unroll
        for (int a = 0; a < 2; ++a)
#pragma unroll
            for (int b = 0; b < 2; ++b)
#pragma unroll
                for (int m = 0; m < 4; ++m)
#pragma unroll
                    for (int n = 0; n < 2; ++n) acc[a][b][m][n] = (f32x4){0.f, 0.f, 0.f, 0.f};
        cur = nxt; cA = nA; cB = nB; ++ui;
        if constexpr (ALIGN_EPI) { if (wr == 1) PG8_BAR; }
    }
    PG8_WAIT_V(0);
    if constexpr (!ALIGN_EPI) { if (wr == 0) PG8_BAR; }
    PG8_BAR;
    if constexpr (Epi::AFTER_DRAIN) { E.fused(acc, cur, wr, wc, fr, fq, lds, wid, lane); S.done(cur); }
#undef PG8_SA
#undef PG8_SB
#undef PG8_STAGE
#undef PG8_LDA
#undef PG8_LDB
#undef PG8_MMA
#undef PG8_WAIT_V
#undef PG8_WAIT_L
#undef PG8_BAR
#undef PG8_SCHED
}

}

constexpr int NWAVES = 8;
constexpr int D = 1024, NBATCH = 16, L = 2048, CL = 256, M = NBATCH * L, MC = NBATCH * CL, MT = M + MC, NIN = 4608, DFF = 2816, DUP = 5632;
constexpr float EPS = 1e-6f;
constexpr int N_PHASES = 10;
constexpr int MAX_LAUNCH = 4;
#ifndef EXP_TA
#define EXP_TA -1
#endif
#ifndef EXP_TB
#define EXP_TB -1
#endif
#ifndef EXP_AMP
#define EXP_AMP 4
#endif
#define STAMP(i) do { if (EXP_TA >= 0 && ((i) == EXP_TA || (i) == EXP_TB) && blockIdx.x == 0 && threadIdx.x == 0) F.MISC[16 + ((i) == EXP_TB ? 1 : 0)] = (unsigned)__builtin_amdgcn_s_memrealtime(); } while (0)

constexpr size_t MiB = 1u << 20;
constexpr size_t WS_CTL = 0, CTL_ZERO_BYTES = 64 * 1024;
constexpr size_t WS_MOD = 1 * MiB;
constexpr size_t WS_BIAS2 = 1 * MiB + 512 * 1024;
constexpr size_t WS_ROPE = 2 * MiB;
constexpr size_t WS_WIN = 3 * MiB, WS_WOUT = 12 * MiB, WS_WUP = 14 * MiB, WS_WDN = 25 * MiB;
constexpr size_t WS_DF = 31 * MiB, WS_DB = 32 * MiB + 512 * 1024;
constexpr size_t WS_SSQ1 = 34 * MiB;
constexpr size_t WS_EDGEG = 36 * MiB;
constexpr size_t WS_EDGEU = 58 * MiB;
constexpr size_t WS_XBUF = 70 * MiB;
constexpr size_t SKEW = 68 * 1024;
constexpr size_t WS_KF = 72 * MiB, WS_KB = 145 * MiB + 1 * SKEW, WS_V = 218 * MiB + 2 * SKEW;
constexpr size_t WS_QF = 291 * MiB + 3 * SKEW, WS_QB = 356 * MiB + 4 * SKEW, WS_G = 421 * MiB + 5 * SKEW;
constexpr size_t WS_MIXED = WS_G, WS_A2 = WS_QF, WS_X1B = WS_QB, WS_HID = WS_KF;
constexpr size_t WS_END = 486 * MiB;
constexpr int CW_BAR = 4096, CW_MODCNT = 2048, CW_PANEL = 8192;

constexpr int RING_OFF = 0, RING_BYTES = 131072;
constexpr int LDS_BYTES = 163840;
constexpr int LDSCTL_OFF = LDS_BYTES - 1024, MISC_OFF = LDSCTL_OFF + 320;

#define GAS __attribute__((address_space(1)))
#define LAS __attribute__((address_space(3)))
typedef unsigned short bf16;
typedef unsigned v4u __attribute__((ext_vector_type(4)));
typedef unsigned v2u __attribute__((ext_vector_type(2)));
typedef float f32x4 __attribute__((ext_vector_type(4)));
typedef short bf16x8 __attribute__((ext_vector_type(8)));
typedef GAS unsigned gu32;
#define RLX_AGENT __ATOMIC_RELAXED, __HIP_MEMORY_SCOPE_AGENT
#define LDS_WAIT() asm volatile("s_waitcnt lgkmcnt(0)" ::: "memory")
#define VM_WAIT() asm volatile("s_waitcnt vmcnt(0)" ::: "memory")
__device__ __forceinline__ unsigned f2bf(float f) { unsigned u = __builtin_bit_cast(unsigned, f); return (u + 0x7fffu + ((u >> 16) & 1u)) >> 16; }
__device__ __forceinline__ unsigned pk2(float lo, float hi) { return f2bf(lo) | (f2bf(hi) << 16); }
__device__ __forceinline__ float bf2f(unsigned short h) { return __builtin_bit_cast(float, (unsigned)h << 16); }
__device__ __forceinline__ float sigm(float x) { return __builtin_amdgcn_rcpf(1.f + __expf(-x)); }
__device__ __forceinline__ float siluf(float x) { return x * __builtin_amdgcn_rcpf(1.f + __expf(-x)); }

#define XB_TMO      128
#define XB_XCNT(j)  (256  + 64 * (j))
#define XB_XSUB(j)  (1280 + 64 * (j))
#define XB_XGEN(j)  (2304 + 64 * (j))
#define XB_TOP      3328
#define XB_TOPGEN   3392
#define XCD_BAR_WORDS 3456
#define XB_SPIN_CAP (1u << 18)

__device__ __forceinline__ unsigned xb_ld(unsigned* p)              { return __hip_atomic_load(p, __ATOMIC_RELAXED, __HIP_MEMORY_SCOPE_AGENT); }
__device__ __forceinline__ unsigned xb_add(unsigned* p, unsigned v) { return __hip_atomic_fetch_add(p, v, __ATOMIC_RELAXED, __HIP_MEMORY_SCOPE_AGENT); }
__device__ __forceinline__ unsigned xb_xcc_id() { return (unsigned)__builtin_amdgcn_s_getreg((3 << 11) | 20) & 0xFu; }
#define XB_SPIN(cond, bar) do { unsigned _sp = 0; while (cond) { __builtin_amdgcn_s_sleep(1); \
    if ((++_sp & 255u) == 0u) { if (xb_ld(&(bar)[XB_TMO])) break; if (_sp > XB_SPIN_CAP) { atomicAdd(&(bar)[XB_TMO], 1u); break; } } } } while (0)

struct XcdBarrier {
    unsigned* bar; unsigned x; int wave;
    volatile LAS unsigned* st;
};

__device__ __forceinline__ XcdBarrier xcd_barrier_post(unsigned* bar, volatile LAS unsigned* st) {
    XcdBarrier b; b.bar = bar; b.x = xb_xcc_id(); b.st = st; b.wave = __builtin_amdgcn_readfirstlane((int)threadIdx.x >> 6);
    if (threadIdx.x == 0) (void)xb_add(&bar[XB_XCNT(b.x)], 1u);
    return b;
}
__device__ __forceinline__ void xcd_barrier_complete(unsigned* bar, unsigned x, unsigned& nloc, unsigned& nx) {
    const unsigned G = gridDim.x * gridDim.y * gridDim.z;
    unsigned sum, cnt, mine, sp = 0u;
    for (;;) {
        sum = 0u; cnt = 0u; mine = 0u;
#pragma unroll
        for (unsigned j = 0; j < 16; ++j) { const unsigned c = xb_ld(&bar[XB_XCNT(j)]); sum += c; cnt += (c > 0u) ? 1u : 0u; mine = (j == x) ? c : mine; }
        if (sum == G) break;
        __builtin_amdgcn_s_sleep(1);
        if ((++sp & 255u) == 0u) { if (xb_ld(&bar[XB_TMO])) break; if (sp > XB_SPIN_CAP) { atomicAdd(&bar[XB_TMO], 1u); break; } }
    }
    nloc = mine > 0u ? mine : 1u; nx = cnt > 0u ? cnt : 1u;
}

__device__ __forceinline__ void xcd_barrier(const XcdBarrier& b) {
    asm volatile("s_waitcnt vmcnt(0)" ::: "memory");
    __syncthreads();
    if (b.wave == 0 && (int)__builtin_amdgcn_mbcnt_hi(~0u, __builtin_amdgcn_mbcnt_lo(~0u, 0u)) == 0) {
        unsigned* bar = b.bar;
        __builtin_amdgcn_s_waitcnt(0);
        unsigned nloc = b.st[0], nx = b.st[1];
        if (nloc == 0u) { xcd_barrier_complete(bar, b.x, nloc, nx); b.st[0] = nloc; b.st[1] = nx; }
        const unsigned old = xb_add(&bar[XB_XSUB(b.x)], 1u);
        const unsigned gen = old / nloc;
        if (old + 1u == (gen + 1u) * nloc) {
            __builtin_amdgcn_fence(__ATOMIC_RELEASE, "agent");
            asm volatile("s_waitcnt vmcnt(0)" ::: "memory");
            const unsigned og = xb_add(&bar[XB_TOP], 1u);
            const unsigned tg = og / nx;
            if (og + 1u == (tg + 1u) * nx) xb_add(&bar[XB_TOPGEN], 1u);
            else XB_SPIN(xb_ld(&bar[XB_TOPGEN]) == tg, bar);
            __builtin_amdgcn_fence(__ATOMIC_ACQUIRE, "agent");
            xb_add(&bar[XB_XGEN(b.x)], 1u);
            asm volatile("s_waitcnt vmcnt(0)" ::: "memory");
        } else {
            XB_SPIN(xb_ld(&bar[XB_XGEN(b.x)]) == gen, bar);
            __builtin_amdgcn_fence(__ATOMIC_ACQUIRE, "agent");
            asm volatile("s_waitcnt vmcnt(0)" ::: "memory");
        }
    }
    __syncthreads();
}


struct Frame {
    LAS unsigned char* lds;
    volatile LAS unsigned* MISC;
    gu32* ctl;
    int tid, lane, wave;
    int vcu, G;
    unsigned char* ws;
    const float *x, *c, *ctx, *c_ctx, *w_mod, *b_mod, *norm1_g, *w_in, *hgrn_lb, *hgrn_norm_g, *ret_decay, *ret_norm_g, *w_out, *norm2_g, *w_up, *conv_w, *conv_b, *w_down, *final_g;
    float* out;
};
__device__ __forceinline__ int cur_lane() { return (int)__builtin_amdgcn_mbcnt_hi(~0u, __builtin_amdgcn_mbcnt_lo(~0u, 0u)); }
#define REFRESH_IDS() do { int l_ = cur_lane(); asm volatile("" : "+v"(l_)); F.lane = l_; F.tid = F.wave * 64 + l_; } while (0)
__device__ __forceinline__ float wave_sum(float v) {
#pragma unroll
    for (int o = 1; o < 64; o <<= 1) v += __shfl_xor(v, o);
    return v;
}

__device__ __forceinline__ int ropeperm(int p) { const int half = p >> 6, pp = p & 63; return 64 * half + (pp >> 1) + 32 * (pp & 1); }
__device__ __forceinline__ int win_colmap(int phys) {
    const int tile = phys >> 8, c = phys & 255;
    if (tile < 8) {
        const int h = tile >> 1, kh = tile & 1, bj = c >> 7, cc = c & 127, jp = cc >> 3, n = (cc >> 2) & 1, i = cc & 3, key = 64 * kh + 4 * jp + i;
        const int grp = bj == 0 ? (n == 0 ? 0 : 1024) : (n == 0 ? 1536 : 512);
        return grp + h * 128 + key;
    }
    if (tile < 10) return 2048 + (tile - 8) * 256 + c;
    if (tile < 12) return 2560 + (2 * (tile - 10) + (c >> 7)) * 128 + ropeperm(c & 127);
    if (tile < 14) return 3072 + (2 * (tile - 12) + (c >> 7)) * 128 + ropeperm(c & 127);
    if (tile < 16) return 3584 + (tile - 14) * 256 + c;
    return 4096 + (tile - 16) * 256 + c;
}
__device__ __forceinline__ int wup_colmap(int phys) { const int j = phys >> 8, c = phys & 255; return c < 128 ? 128 * j + c : DFF + 128 * j + (c - 128); }
__device__ __forceinline__ int win_inv(int col) {
    const int grp = col >> 9, hcol = col & 511, h = hcol >> 7, key = hcol & 127;
    if (grp <= 3) { const int tile = 2 * h + (key >> 6), kk = key & 63, jp = kk >> 2, i = kk & 3;
        const int sub = grp == 0 ? 0 : (grp == 2 ? 4 : (grp == 3 ? 128 : 132));
        return 256 * tile + sub + 8 * jp + i; }
    if (grp == 5 || grp == 6) { const int half = key >> 6, l6 = key & 63, pp = 2 * (l6 & 31) + (l6 >> 5); return col - key + 64 * half + pp; }
    return col;
}
__device__ __forceinline__ int wup_inv(int col) { return col < DFF ? 256 * (col >> 7) + (col & 127) : 256 * ((col - DFF) >> 7) + 128 + ((col - DFF) & 127); }

struct TrItem { const float* W; bf16* WT; int K, N, map, item; };
constexpr int TR_I_IN = (D / 64) * (NIN / 32), TR_I_ALL = TR_I_IN + (D / 64) * (D / 32) + (D / 64) * (DUP / 32) + (DFF / 64) * (D / 32);
__device__ __forceinline__ bool tr_item(const Frame& F, int it, TrItem& t) {
    constexpr int I_IN = (D / 64) * (NIN / 32), I_O = (D / 64) * (D / 32), I_UP = (D / 64) * (DUP / 32), I_DN = (DFF / 64) * (D / 32);
    int r = it;
    if (r < I_IN) { t = TrItem{F.w_in, (bf16*)(F.ws + WS_WIN), D, NIN, 1, r}; return true; } r -= I_IN;
    if (r < I_O) { t = TrItem{F.w_out, (bf16*)(F.ws + WS_WOUT), D, D, 0, r}; return true; } r -= I_O;
    if (r < I_UP) { t = TrItem{F.w_up, (bf16*)(F.ws + WS_WUP), D, DUP, 2, r}; return true; } r -= I_UP;
    if (r < I_DN) { t = TrItem{F.w_down, (bf16*)(F.ws + WS_WDN), DFF, D, 0, r}; return true; }
    return false;
}
__device__ __forceinline__ void tr_load(const TrItem& t, f32x4 (&v)[8], int lane) {
    const int nblk = t.N / 32, kb = t.item / nblk, nb = t.item % nblk, k0 = 64 * kb, n0 = 32 * nb;
    const float* src = t.W + (size_t)(k0 + (lane >> 3)) * t.N + n0 + 4 * (lane & 7);
#pragma unroll
    for (int i = 0; i < 8; ++i) v[i] = __builtin_nontemporal_load((const f32x4*)(src + (size_t)(8 * i) * t.N));
}
__device__ __forceinline__ void tr_store(const TrItem& t, const f32x4 (&v)[8], LAS float* scr, int lane) {
    const int nblk = t.N / 32, kb = t.item / nblk, nb = t.item % nblk, k0 = 64 * kb, n0 = 32 * nb;
#pragma unroll
    for (int i = 0; i < 8; ++i) { LAS float* d = scr + (8 * i + (lane >> 3)) * 33 + 4 * (lane & 7); d[0] = v[i].x; d[1] = v[i].y; d[2] = v[i].z; d[3] = v[i].w; }
    LDS_WAIT(); asm volatile("" ::: "memory");
    const int c = lane & 7;
#pragma unroll
    for (int j = 0; j < 4; ++j) { const int n = (lane >> 3) + 8 * j, nl = n0 + n, nphys = t.map == 0 ? nl : (t.map == 1 ? win_inv(nl) : wup_inv(nl)); const LAS float* s = scr + (8 * c) * 33 + n;
        v4u o; o.x = pk2(s[0 * 33], s[1 * 33]); o.y = pk2(s[2 * 33], s[3 * 33]); o.z = pk2(s[4 * 33], s[5 * 33]); o.w = pk2(s[6 * 33], s[7 * 33]);
        *(GAS v4u*)(t.WT + (size_t)nphys * t.K + k0 + 8 * c) = o; }
    LDS_WAIT(); asm volatile("" ::: "memory");
}

__device__ __forceinline__ void p0_mod(Frame& F, int cg) {
    LAS float* scr = (LAS float*)(F.lds) + F.wave * (17 * 128);
    LAS float* red = (LAS float*)(F.lds + 8 * 17 * 128 * 4);
    float* MOD = (float*)(F.ws + WS_MOD);
    const int k0 = F.wave * 128, kh = F.lane >> 5, col = F.lane & 31;
    const float* wp = F.w_mod + (size_t)(k0 + kh) * 6144 + cg * 32 + col;
    {
        float cv[34];
#pragma unroll
        for (int q = 0; q < 34; ++q) { const int r = q >> 1, kk = F.lane + 64 * (q & 1); cv[q] = r < 16 ? F.c[r * D + k0 + kk] : F.c_ctx[k0 + kk]; }
#pragma unroll
        for (int q = 0; q < 34; ++q) { const int r = q >> 1, kk = F.lane + 64 * (q & 1); scr[r * 128 + kk] = cv[q] / (1.f + __expf(-cv[q])); }
    }
    LDS_WAIT(); asm volatile("" ::: "memory");
    float acc[17];
#pragma unroll
    for (int r = 0; r < 17; ++r) acc[r] = 0.f;
    for (int i0 = 0; i0 < 64; i0 += 32) {
        float w[32];
#pragma unroll
        for (int i = 0; i < 32; ++i) w[i] = __builtin_nontemporal_load(wp + (size_t)(2 * (i0 + i)) * 6144);
#pragma unroll
        for (int i = 0; i < 32; ++i) {
#pragma unroll
            for (int r = 0; r < 17; ++r) acc[r] += scr[r * 128 + 2 * (i0 + i) + kh] * w[i]; }
    }
#pragma unroll
    for (int r = 0; r < 17; ++r) { acc[r] += __shfl_xor(acc[r], 32); if (kh == 0) red[(F.wave * 17 + r) * 32 + col] = acc[r]; }
    __syncthreads();
    for (int o = F.tid; o < 17 * 32; o += NWAVES * 64) { const int r = o >> 5, cc = o & 31; float s = F.b_mod[cg * 32 + cc];
#pragma unroll
        for (int ww = 0; ww < 8; ++ww) s += red[(ww * 17 + r) * 32 + cc];
        __hip_atomic_store(MOD + (size_t)r * 6144 + cg * 32 + cc, s, __ATOMIC_RELAXED, __HIP_MEMORY_SCOPE_AGENT); }
    asm volatile("s_waitcnt vmcnt(0)" ::: "memory");
    __syncthreads();
    if (F.tid == 0) __hip_atomic_fetch_add((unsigned*)(F.ctl + CW_MODCNT), 1u, __ATOMIC_RELAXED, __HIP_MEMORY_SCOPE_AGENT);
}
__device__ __forceinline__ void mod_wait(Frame& F) {
    if (F.tid == 0) {
        unsigned sp = 0;
        while (__hip_atomic_load((unsigned*)(F.ctl + CW_MODCNT), __ATOMIC_RELAXED, __HIP_MEMORY_SCOPE_AGENT) < 192u) { __builtin_amdgcn_s_sleep(2); if (++sp > (1u << 22)) break; }
        __builtin_amdgcn_fence(__ATOMIC_ACQUIRE, "agent");
        asm volatile("s_waitcnt vmcnt(0)" ::: "memory");
    }
    __syncthreads();
}

__device__ __forceinline__ void p0_prologue(Frame& F) {
    STAMP(20); if (F.vcu < 192) p0_mod(F, F.vcu); STAMP(21);
    if (F.vcu == 192) {
        float2* T = (float2*)(F.ws + WS_ROPE);
        for (int e = F.tid; e < 64 * 32; e += NWAVES * 64) { const int pos = e >> 5, i = e & 31; const float ang = (float)pos * powf(10000.f, -(float)i / 32.f); T[e] = make_float2(cosf(ang), sinf(ang)); }
    }
    {
        const int gw = F.vcu * NWAVES + F.wave, NGW = F.G * NWAVES;
        LAS float* scr = (LAS float*)(F.lds + RING_OFF + F.wave * 16384);
        for (int it = NGW - 1 - gw; it < TR_I_IN; it += 2 * NGW) {
            TrItem t0, t1; f32x4 v0[8], v1[8]; const bool h0 = tr_item(F, it, t0), h1 = (it + NGW) < TR_I_IN && tr_item(F, it + NGW, t1);
            if (h0) tr_load(t0, v0, F.lane); if (h1) tr_load(t1, v1, F.lane);
            if (h0) tr_store(t0, v0, scr, F.lane); if (h1) tr_store(t1, v1, scr, F.lane);
        }
    }
    STAMP(22);
}

__device__ __forceinline__ void p1_tables(Frame& F) {
    LAS unsigned char* tab = F.lds + RING_BYTES;
    const unsigned char* rope = F.ws + WS_ROPE;
    for (int ch = F.tid; ch < 1024; ch += NWAVES * 64) { const int pos = ch >> 4; *(LAS f32x4*)(tab + ((pos & 3) * 16 + (pos >> 2)) * 272 + (ch & 15) * 16) = *(const f32x4*)(rope + ch * 16); }
    { const int t = F.tid; const float a0f = F.hgrn_lb[t], a1f = F.hgrn_lb[512 + t], a0b = F.hgrn_lb[1024 + t], a1b = F.hgrn_lb[1536 + t];
      *(LAS float*)(tab + 64 * 272 + t * 4) = __builtin_amdgcn_rcpf(1.f + __expf(a1f - a0f)); *(LAS float*)(tab + 64 * 272 + 2048 + t * 4) = __builtin_amdgcn_rcpf(1.f + __expf(a1b - a0b));
      if (t < 8) *(LAS float*)(tab + 64 * 272 + 4096 + t * 4) = -log1pf(expf(-F.ret_decay[t])); }
    __syncthreads();
}
__device__ __forceinline__ void late_transposes(Frame& F) {
    const int bx = (int)blockIdx.x; const bool part = F.G == 256; if (part && bx < 192) return;
    const int nw = part ? 64 * NWAVES : F.G * NWAVES, iw = part ? (bx - 192) * NWAVES + F.wave : bx * NWAVES + F.wave;
    LAS float* scr = (LAS float*)(F.lds + RING_OFF + F.wave * 16384);
    for (int it = TR_I_IN + iw; it < TR_I_ALL; it += 2 * nw) {
        TrItem t0, t1; f32x4 v0[8], v1[8]; const bool h0 = tr_item(F, it, t0), h1 = (it + nw) < TR_I_ALL && tr_item(F, it + nw, t1);
        if (h0) tr_load(t0, v0, F.lane); if (h1) tr_load(t1, v1, F.lane);
        if (h0) tr_store(t0, v0, scr, F.lane); if (h1) tr_store(t1, v1, scr, F.lane);
    }
}

__device__ __forceinline__ void bias2_phase(Frame& F) {
    const float* MOD = (const float*)(F.ws + WS_MOD);
    {
        typedef float f32x4a __attribute__((ext_vector_type(4)));
        typedef __bf16 bf8v __attribute__((ext_vector_type(8)));
        typedef float f32x8v __attribute__((ext_vector_type(8)));
        const bf16* WUP = (const bf16*)(F.ws + WS_WUP); float* B2 = (float*)(F.ws + WS_BIAS2);
        LAS f32x4a* red = (LAS f32x4a*)(F.lds);
        for (int t = F.vcu; t < DUP / 16; t += F.G) {
            const int bl = F.lane & 15, kq = F.lane >> 4;
            f32x4a acc = {0.f, 0.f, 0.f, 0.f};
#pragma unroll
            for (int ks = 0; ks < 4; ++ks) {
                const int k = 128 * F.wave + 32 * ks + 8 * kq;
                const f32x4a p = *(const f32x4a*)(MOD + (size_t)bl * 6144 + 3072 + k), q = *(const f32x4a*)(MOD + (size_t)bl * 6144 + 3072 + k + 4);
                f32x8v pq; pq[0] = p.x; pq[1] = p.y; pq[2] = p.z; pq[3] = p.w; pq[4] = q.x; pq[5] = q.y; pq[6] = q.z; pq[7] = q.w;
                const bf16x8 af = __builtin_bit_cast(bf16x8, __builtin_convertvector(pq, bf8v));
                const bf16x8 bfr = *(const GAS bf16x8*)(WUP + (size_t)(16 * t + bl) * D + k);
                acc = __builtin_amdgcn_mfma_f32_16x16x32_bf16(af, bfr, acc, 0, 0, 0);
            }
            red[F.wave * 64 + F.lane] = acc;
            __syncthreads();
            if (F.wave == 0) { f32x4a sum = red[F.lane];
#pragma unroll
                for (int w = 1; w < 8; ++w) sum += red[w * 64 + F.lane];
#pragma unroll
                for (int rg = 0; rg < 4; ++rg) B2[(size_t)(4 * kq + rg) * DUP + 16 * t + bl] = sum[rg]; }
            __syncthreads();
        }
    }
}

__device__ __forceinline__ void p0b_phase(Frame& F, bf16* xn) {
    const int gw = F.vcu * NWAVES + F.wave, NGW = F.G * NWAVES;
    const float* MOD = (const float*)(F.ws + WS_MOD);
    STAMP(50);
    {
        constexpr int RPI = 3;
        int curb = -1; f32x4 gs[4], sh[4];
        for (int m0 = RPI * gw; m0 < MT; m0 += RPI * NGW) {
            f32x4 v[RPI][4];
#pragma unroll
            for (int q = 0; q < RPI; ++q) { const int m = (m0 + q) < MT ? (m0 + q) : (MT - 1);
                const float* xrow = m < M ? F.x + (size_t)m * D : F.ctx + (size_t)(m - M) * D; const GAS f32x4* xr = (const GAS f32x4*)xrow + F.lane;
#pragma unroll
                for (int j = 0; j < 4; ++j) v[q][j] = __builtin_nontemporal_load(xr + 64 * j); }
#pragma unroll
            for (int q = 0; q < RPI; ++q) { const int m = m0 + q; if (m < MT) {
                const int bidx = m < M ? m / L : 16;
                if (bidx != curb) {
#pragma unroll
                    for (int j = 0; j < 4; ++j) { const int kk = 4 * F.lane + 256 * j; const f32x4 g = *(const f32x4*)(F.norm1_g + kk), sc = *(const f32x4*)(MOD + (size_t)bidx * 6144 + 1024 + kk);
                        gs[j] = g * (1.f + sc); sh[j] = *(const f32x4*)(MOD + (size_t)bidx * 6144 + kk); }
                    curb = bidx;
                }
                float s_ = 0.f;
#pragma unroll
                for (int j = 0; j < 4; ++j) s_ += (v[q][j].x * v[q][j].x + v[q][j].y * v[q][j].y) + (v[q][j].z * v[q][j].z + v[q][j].w * v[q][j].w);
                const float rstd = rsqrtf(wave_sum(s_) * (1.f / D) + EPS);
                GAS v2u* o8 = (GAS v2u*)(xn + (size_t)m * D) + F.lane;
#pragma unroll
                for (int j = 0; j < 4; ++j) { const f32x4 y = v[q][j] * rstd * gs[j] + sh[j]; v2u w; w.x = pg8::cvt_pk_bf16(y.x, y.y); w.y = pg8::cvt_pk_bf16(y.z, y.w); o8[64 * j] = w; } } }
        }
    }
    STAMP(52);
}

using pg8::Unit;
template <int CTRL> __device__ __forceinline__ float dppf(float x) { return __builtin_bit_cast(float, __builtin_amdgcn_update_dpp(0, __builtin_bit_cast(int, x), CTRL, 0xF, 0xF, false)); }

struct EpiOut {
    static constexpr bool PERM = true, AFTER_DRAIN = false, APERM = false; static constexpr int STAMP_PH = 5;
    const float* x; bf16* x1; bf16* a2; const float* mod; const float* n2g; float* ssq;
    __device__ __forceinline__ void operator()(const f32x4 (&acc)[2][2][4][2], const Unit& u, int wr, int wc, int fr, int fq) const {
        asm volatile("" : "+v"(fr), "+v"(fq));
        const int b = (u.pm * 256) / L, colb = u.pn * 256 + wc * 32 + 8 * fq;
        f32x4 g1v[2][2], gsv[2][2];
#pragma unroll
        for (int bj = 0; bj < 2; ++bj)
#pragma unroll
            for (int n = 0; n < 2; ++n) { const int c = colb + bj * 128 + 4 * n;
                g1v[bj][n] = *(const f32x4*)(mod + (size_t)b * 6144 + 2048 + c);
                gsv[bj][n] = *(const f32x4*)(n2g + c) * (1.f + *(const f32x4*)(mod + (size_t)b * 6144 + 4096 + c)); }
#pragma unroll
        for (int ai = 0; ai < 2; ++ai) {
            f32x4 xa[4][2], xb[4][2];
#pragma unroll
            for (int m = 0; m < 4; ++m)
#pragma unroll
                for (int bj = 0; bj < 2; ++bj) { const size_t off = ((size_t)u.pm * 256 + ai * 128 + wr * 64 + m * 16 + fr) * D + colb + bj * 128; xa[m][bj] = __builtin_nontemporal_load((const f32x4*)(x + off)); xb[m][bj] = __builtin_nontemporal_load((const f32x4*)(x + off + 4)); }
            __builtin_amdgcn_sched_barrier(0);
#pragma unroll
            for (int m = 0; m < 4; ++m) {
                const size_t row = (size_t)u.pm * 256 + ai * 128 + wr * 64 + m * 16 + fr; float q = 0.f;
#pragma unroll
                for (int bj = 0; bj < 2; ++bj) {
                    const size_t off = row * D + colb + bj * 128;
                    const f32x4 v0 = xa[m][bj] + g1v[bj][0] * acc[ai][bj][m][0], v1 = xb[m][bj] + g1v[bj][1] * acc[ai][bj][m][1];
                    { v4u w1; w1.x = pg8::cvt_pk_bf16(v0.x, v0.y); w1.y = pg8::cvt_pk_bf16(v0.z, v0.w); w1.z = pg8::cvt_pk_bf16(v1.x, v1.y); w1.w = pg8::cvt_pk_bf16(v1.z, v1.w); *(v4u*)(x1 + off) = w1; }
                    q += (v0.x * v0.x + v0.y * v0.y) + (v0.z * v0.z + v0.w * v0.w) + (v1.x * v1.x + v1.y * v1.y) + (v1.z * v1.z + v1.w * v1.w);
                    const f32x4 a0 = v0 * gsv[bj][0], a1 = v1 * gsv[bj][1];
                    v4u w; w.x = pg8::cvt_pk_bf16(a0.x, a0.y); w.y = pg8::cvt_pk_bf16(a0.z, a0.w); w.z = pg8::cvt_pk_bf16(a1.x, a1.y); w.w = pg8::cvt_pk_bf16(a1.z, a1.w);
                    *(v4u*)(a2 + off) = w;
                }
                q += __shfl_xor(q, 16); q += __shfl_xor(q, 32);
                if (fq == 0) ssq[row * 16 + u.pn * 4 + wc] = q;
            }
        }
    }
};

struct EpiUp {
    static constexpr bool PERM = true, AFTER_DRAIN = false, APERM = true; static constexpr int STAMP_PH = 6;
    const float* ssq1; const float* bias2; const float* cw; const float* cb; bf16* hid; float* edge_g; float* edge_u;
    __device__ __forceinline__ void operator()(const f32x4 (&acc)[2][2][4][2], const Unit& u, int wr, int wc, int fr, int fq) const {
        asm volatile("" : "+v"(fr), "+v"(fq));
        const int b = (u.pm * 256) / L, j = u.pn, cc0 = wc * 32 + 8 * fq;
        f32x4 sp[2][4], bg[2], bu[2], cw0[2], cw1[2], cw2[2], cbv[2];
#pragma unroll
        for (int ai = 0; ai < 2; ++ai)
#pragma unroll
            for (int m = 0; m < 4; ++m) sp[ai][m] = *(const f32x4*)(ssq1 + (size_t)(u.pm * 256 + ai * 128 + wr * 64 + 4 * fr + m) * 16 + 4 * fq);
#pragma unroll
        for (int n = 0; n < 2; ++n) { const int c = 128 * j + cc0 + 4 * n;
            bg[n] = *(const f32x4*)(bias2 + (size_t)b * DUP + 256 * j + cc0 + 4 * n); bu[n] = *(const f32x4*)(bias2 + (size_t)b * DUP + 256 * j + 128 + cc0 + 4 * n);
            cw0[n] = *(const f32x4*)(cw + c); cw1[n] = *(const f32x4*)(cw + DFF + c); cw2[n] = *(const f32x4*)(cw + 2 * DFF + c); cbv[n] = *(const f32x4*)(cb + c); }
        __builtin_amdgcn_sched_barrier(0);
        float rs[2][4];
#pragma unroll
        for (int ai = 0; ai < 2; ++ai)
#pragma unroll
            for (int m = 0; m < 4; ++m) { float s_ = (sp[ai][m].x + sp[ai][m].y) + (sp[ai][m].z + sp[ai][m].w); s_ += __shfl_xor(s_, 16); s_ += __shfl_xor(s_, 32); rs[ai][m] = rsqrtf(s_ * (1.f / D) + EPS); }
#pragma unroll
        for (int ai = 0; ai < 2; ++ai) {
            const int row0 = u.pm * 256 + ai * 128 + wr * 64, blk = row0 >> 6;
            f32x4 Gv[2][4], pv[2], nx[2];
#pragma unroll
            for (int n = 0; n < 2; ++n) {
#pragma unroll
                for (int m = 0; m < 4; ++m) Gv[n][m] = acc[ai][0][m][n] * rs[ai][m] + bg[n];
#pragma unroll
                for (int i = 0; i < 4; ++i) { pv[n][i] = dppf<0x111>(Gv[n][3][i]); nx[n][i] = dppf<0x101>(Gv[n][0][i]); }
            }
#pragma unroll
            for (int m = 0; m < 4; ++m) {
                v4u w;
#pragma unroll
                for (int n = 0; n < 2; ++n) {
                    const int c = 128 * j + cc0 + 4 * n;
                    const f32x4 Uv = acc[ai][1][m][n] * rs[ai][m] + bu[n];
                    const f32x4 prev = m > 0 ? Gv[n][m > 0 ? m - 1 : 0] : pv[n], next = m < 3 ? Gv[n][m < 3 ? m + 1 : 3] : nx[n];
                    const f32x4 gt = cw0[n] * prev + cw1[n] * Gv[n][m] + cw2[n] * next + cbv[n];
                    f32x4 h; h.x = siluf(gt.x) * Uv.x; h.y = siluf(gt.y) * Uv.y; h.z = siluf(gt.z) * Uv.z; h.w = siluf(gt.w) * Uv.w;
                    if (n == 0) { w.x = pg8::cvt_pk_bf16(h.x, h.y); w.y = pg8::cvt_pk_bf16(h.z, h.w); } else { w.z = pg8::cvt_pk_bf16(h.x, h.y); w.w = pg8::cvt_pk_bf16(h.z, h.w); }
                    if (m == 0 && fr == 0) *(f32x4*)(edge_u + ((size_t)blk * 2 + 0) * DFF + c) = Uv;
                    if (m == 3 && fr == 15) *(f32x4*)(edge_u + ((size_t)blk * 2 + 1) * DFF + c) = Uv;
                }
                const bool interior = !((m == 0 && fr == 0) || (m == 3 && fr == 15));
                if (interior) *(v4u*)(hid + (size_t)(row0 + 4 * fr + m) * DFF + 128 * j + cc0) = w;
            }
#pragma unroll
            for (int n = 0; n < 2; ++n) { const int c = 128 * j + cc0 + 4 * n;
                if (fr == 0) { *(f32x4*)(edge_g + ((size_t)blk * 4 + 0) * DFF + c) = Gv[n][0]; *(f32x4*)(edge_g + ((size_t)blk * 4 + 1) * DFF + c) = Gv[n][1]; }
                if (fr == 15) { *(f32x4*)(edge_g + ((size_t)blk * 4 + 2) * DFF + c) = Gv[n][2]; *(f32x4*)(edge_g + ((size_t)blk * 4 + 3) * DFF + c) = Gv[n][3]; } }
        }
    }
};

struct EpiDownNorm {
    static constexpr bool PERM = true, AFTER_DRAIN = false, APERM = false; static constexpr int STAMP_PH = 8;
    const bf16* x1; float* out; const float* mod; const float* fg; float* xbuf; unsigned* cnt; LAS unsigned char* sp;
    __device__ __forceinline__ void operator()(const f32x4 (&acc_)[2][2][4][2], const Unit& u, int wr, int wc, int fr, int fq) const {
        asm volatile("" : "+v"(fr), "+v"(fq));
        f32x4 (&acc)[2][2][4][2] = const_cast<f32x4 (&)[2][2][4][2]>(acc_);
        const int b = (u.pm * 256) / L, colb = u.pn * 256 + wc * 32 + 8 * fq, wid = wr * 4 + wc, lane = fq * 16 + fr;
        LAS float* P = (LAS float*)sp; LAS float* S = (LAS float*)(sp + 4096); LAS unsigned* flag = (LAS unsigned*)(sp + 5120);
        f32x4 g2v[2][2];
#pragma unroll
        for (int bj = 0; bj < 2; ++bj)
#pragma unroll
            for (int n = 0; n < 2; ++n) g2v[bj][n] = *(const f32x4*)(mod + (size_t)b * 6144 + 5120 + colb + bj * 128 + 4 * n);
#pragma unroll
        for (int ai = 0; ai < 2; ++ai) {
            v4u xw[4][2];
#pragma unroll
            for (int m = 0; m < 4; ++m)
#pragma unroll
                for (int bj = 0; bj < 2; ++bj) xw[m][bj] = __builtin_nontemporal_load((const v4u*)(x1 + ((size_t)u.pm * 256 + ai * 128 + wr * 64 + m * 16 + fr) * D + colb + bj * 128));
            __builtin_amdgcn_sched_barrier(0);
#pragma unroll
            for (int m = 0; m < 4; ++m) { float q = 0.f;
#pragma unroll
                for (int bj = 0; bj < 2; ++bj) { const v4u w = xw[m][bj];
                    const f32x4 xa = {bf2f(w.x & 0xffff), bf2f(w.x >> 16), bf2f(w.y & 0xffff), bf2f(w.y >> 16)}, xb = {bf2f(w.z & 0xffff), bf2f(w.z >> 16), bf2f(w.w & 0xffff), bf2f(w.w >> 16)};
                    const f32x4 y0 = xa + g2v[bj][0] * acc[ai][bj][m][0], y1 = xb + g2v[bj][1] * acc[ai][bj][m][1]; acc[ai][bj][m][0] = y0; acc[ai][bj][m][1] = y1;
                    q += (y0.x * y0.x + y0.y * y0.y) + (y0.z * y0.z + y0.w * y0.w) + (y1.x * y1.x + y1.y * y1.y) + (y1.z * y1.z + y1.w * y1.w); }
                q += __shfl_xor(q, 16); q += __shfl_xor(q, 32);
                if (fq == 0) P[(ai * 128 + wr * 64 + m * 16 + fr) * 4 + wc] = q; }
        }
        asm volatile("s_waitcnt lgkmcnt(0)" ::: "memory"); __builtin_amdgcn_s_barrier(); asm volatile("" ::: "memory");
        const int row = wid * 32 + (lane & 31);
        if (lane < 32) { const float t = (P[row * 4 + 0] + P[row * 4 + 1]) + (P[row * 4 + 2] + P[row * 4 + 3]);
            __hip_atomic_store(xbuf + ((size_t)u.pm * 256 + row) * 4 + u.pn, t, __ATOMIC_RELAXED, __HIP_MEMORY_SCOPE_AGENT); }
        asm volatile("s_waitcnt vmcnt(0)" ::: "memory");
        if (lane == 0) __hip_atomic_fetch_add(cnt + 64 * u.pm, 1u, __ATOMIC_RELAXED, __HIP_MEMORY_SCOPE_AGENT);
        if (wid == 0) {
            unsigned spn = 0;
            while ((unsigned)__builtin_amdgcn_readfirstlane(__hip_atomic_load(cnt + 64 * u.pm, __ATOMIC_RELAXED, __HIP_MEMORY_SCOPE_AGENT)) < 32u) { __builtin_amdgcn_s_sleep(2); if (++spn > (1u << 22)) break; }
            __builtin_amdgcn_fence(__ATOMIC_ACQUIRE, "agent");
            if (lane == 0) flag[0] = spn;
        }
        asm volatile("s_waitcnt vmcnt(0) lgkmcnt(0)" ::: "memory"); __builtin_amdgcn_s_barrier(); asm volatile("" ::: "memory");
        if (lane < 32) { const float* slot = xbuf + ((size_t)u.pm * 256 + row) * 4; float t = 0.f;
#pragma unroll
            for (int k = 0; k < 4; ++k) t += __hip_atomic_load(slot + k, __ATOMIC_RELAXED, __HIP_MEMORY_SCOPE_AGENT);
            S[row] = rsqrtf(t * (1.f / D) + EPS); }
        asm volatile("s_waitcnt lgkmcnt(0)" ::: "memory"); __builtin_amdgcn_s_barrier(); asm volatile("" ::: "memory");
        f32x4 fgv[2][2];
#pragma unroll
        for (int bj = 0; bj < 2; ++bj)
#pragma unroll
            for (int n = 0; n < 2; ++n) fgv[bj][n] = *(const f32x4*)(fg + colb + bj * 128 + 4 * n);
#pragma unroll
        for (int ai = 0; ai < 2; ++ai)
#pragma unroll
            for (int m = 0; m < 4; ++m) { const int r = ai * 128 + wr * 64 + m * 16 + fr; const float rs = S[r];
#pragma unroll
                for (int bj = 0; bj < 2; ++bj) { const size_t off = ((size_t)u.pm * 256 + r) * D + colb + bj * 128;
                    *(f32x4*)(out + off) = acc[ai][bj][m][0] * rs * fgv[bj][0]; *(f32x4*)(out + off + 4) = acc[ai][bj][m][1] * rs * fgv[bj][1]; } }
        asm volatile("s_waitcnt lgkmcnt(0)" ::: "memory"); __builtin_amdgcn_s_barrier(); asm volatile("" ::: "memory");
    }
};

struct EpiIn {
    static constexpr bool PERM = true, AFTER_DRAIN = false, APERM = true; static constexpr int STAMP_PH = 2;
    unsigned char* ws; LAS const unsigned char* tab;
    static constexpr int TAB_LB = 64 * 272, TAB_LG = TAB_LB + 4096;
    static __device__ __forceinline__ v2u pk4(const f32x4 a) { v2u w; w.x = pg8::cvt_pk_bf16(a.x, a.y); w.y = pg8::cvt_pk_bf16(a.z, a.w); return w; }
    static __device__ __forceinline__ v4u pk8(const f32x4 a, const f32x4 b) { v4u w; w.x = pg8::cvt_pk_bf16(a.x, a.y); w.y = pg8::cvt_pk_bf16(a.z, a.w); w.z = pg8::cvt_pk_bf16(b.x, b.y); w.w = pg8::cvt_pk_bf16(b.z, b.w); return w; }
    template <int CTRL> static __device__ __forceinline__ float dpp1(float x) { return __builtin_bit_cast(float, __builtin_amdgcn_update_dpp(0x3f800000, __builtin_bit_cast(int, x), CTRL, 0xF, 0xF, false)); }
    static __device__ __forceinline__ void pscan64(f32x4 (&x)[4], f32x4& tot, int fr) {
#pragma unroll
        for (int i = 0; i < 4; ++i) {
            const float p0 = x[0][i], p1 = p0 * x[1][i], p2 = p1 * x[2][i], p3 = p2 * x[3][i];
            float s = p3, a;
            a = dpp1<0x111>(s); s *= a; a = dpp1<0x112>(s); s *= a; a = dpp1<0x114>(s); s *= a; a = dpp1<0x118>(s); s *= a;
            const float e = dpp1<0x111>(s);
            tot[i] = dppf<0x15F>(s);
            x[0][i] = p0 * e; x[1][i] = p1 * e; x[2][i] = p2 * e; x[3][i] = p3 * e;
        }
    }
    static __device__ __forceinline__ void sscan64(f32x4 (&x)[4], f32x4& tot, int fr) {
#pragma unroll
        for (int i = 0; i < 4; ++i) {
            const float s3 = x[3][i], s2 = s3 * x[2][i], s1 = s2 * x[1][i], s0 = s1 * x[0][i];
            float s = s0, a;
            a = dpp1<0x101>(s); s *= a; a = dpp1<0x102>(s); s *= a; a = dpp1<0x104>(s); s *= a; a = dpp1<0x108>(s); s *= a;
            const float e = dpp1<0x101>(s);
            tot[i] = dppf<0x150>(s);
            x[0][i] = s0 * e; x[1][i] = s1 * e; x[2][i] = s2 * e; x[3][i] = s3 * e;
        }
    }
    __device__ __forceinline__ void operator()(const f32x4 (&acc)[2][2][4][2], const Unit& u, int wr, int wc, int fr, int fq) const {
        asm volatile("" : "+v"(fr), "+v"(fq));
        const int tile = u.pn; const bool isctx = u.pm >= 128;
        const int cc0 = wc * 32 + 8 * fq;
        bf16* const qf = (bf16*)(ws + WS_QF); bf16* const kf = (bf16*)(ws + WS_KF); bf16* const qb = (bf16*)(ws + WS_QB); bf16* const kb = (bf16*)(ws + WS_KB); bf16* const v = (bf16*)(ws + WS_V); bf16* const g = (bf16*)(ws + WS_G);
        float* const df = (float*)(ws + WS_DF); float* const db = (float*)(ws + WS_DB);
        if (tile < 8) {
            const int h = tile >> 1, kh = tile & 1, key0 = 64 * kh + 16 * wc + 4 * fq, hc = h * 128 + key0;
            const f32x4 lbf = *(LAS const f32x4*)(tab + TAB_LB + hc * 4), lbb = *(LAS const f32x4*)(tab + TAB_LB + 2048 + hc * 4);
#pragma unroll
            for (int ai = 0; ai < 2; ++ai) {
                const size_t row0 = (size_t)u.pm * 256 + ai * 128 + wr * 64;
                {
                    f32x4 pf[4], kk[4], tot;
#pragma unroll
                    for (int m = 0; m < 4; ++m)
#pragma unroll
                        for (int i = 0; i < 4; ++i) { const float f = lbf[i] + (1.f - lbf[i]) * sigm(acc[ai][0][m][1][i]); pf[m][i] = f; kk[m][i] = 1.f - f; }
                    pscan64(pf, tot, fr);
#pragma unroll
                    for (int m = 0; m < 4; ++m) { const size_t o = (row0 + 4 * fr + m) * D + hc; f32x4 qv, kv;
#pragma unroll
                        for (int i = 0; i < 4; ++i) { qv[i] = acc[ai][0][m][0][i] * pf[m][i]; kv[i] = kk[m][i] * __builtin_amdgcn_rcpf(pf[m][i]); }
                        if (!isctx) *(v2u*)(qf + o) = pk4(qv);
                        *(v2u*)(kf + o) = pk4(kv); *(v2u*)(v + o) = pk4(acc[ai][1][m][1]); }
                    if (fr == 0) *(f32x4*)(df + (row0 >> 6) * 512 + hc) = tot;
                }
                asm volatile("" ::: "memory");
                {
                    f32x4 pf[4], kk[4], tot;
#pragma unroll
                    for (int m = 0; m < 4; ++m)
#pragma unroll
                        for (int i = 0; i < 4; ++i) { const float f = lbb[i] + (1.f - lbb[i]) * sigm(acc[ai][1][m][0][i]); pf[m][i] = f; kk[m][i] = 1.f - f; }
                    sscan64(pf, tot, fr);
#pragma unroll
                    for (int m = 0; m < 4; ++m) { const size_t o = (row0 + 4 * fr + m) * D + hc; f32x4 qv, kv;
#pragma unroll
                        for (int i = 0; i < 4; ++i) { qv[i] = acc[ai][0][m][0][i] * pf[m][i]; kv[i] = kk[m][i] * __builtin_amdgcn_rcpf(pf[m][i]); }
                        if (!isctx) *(v2u*)(qb + o) = pk4(qv);
                        *(v2u*)(kb + o) = pk4(kv); }
                    if (fr == 0) *(f32x4*)(db + (row0 >> 6) * 512 + hc) = tot;
                }
                asm volatile("" ::: "memory");
            }
        } else if (tile < 10 || tile >= 14) {
            const int kind = tile < 10 ? 0 : (tile < 16 ? 1 : 2);
            const int cbase = (kind == 0 ? 256 * (tile - 8) : (kind == 1 ? 512 + 256 * (tile - 14) : 512 + 256 * (tile - 16))) + cc0;
            bf16* dst = kind == 1 ? v : g;
#pragma unroll
            for (int ai = 0; ai < 2; ++ai)
#pragma unroll
                for (int m = 0; m < 4; ++m) { const size_t row = (size_t)u.pm * 256 + ai * 128 + wr * 64 + 4 * fr + m;
#pragma unroll
                    for (int bj = 0; bj < 2; ++bj) { f32x4 a = acc[ai][bj][m][0], b = acc[ai][bj][m][1];
                        if (kind == 0) { for (int i = 0; i < 4; ++i) { a[i] = sigm(a[i]); b[i] = sigm(b[i]); } }
                        if (kind == 2) { for (int i = 0; i < 4; ++i) { a[i] = siluf(a[i]); b[i] = siluf(b[i]); } }
                        *(v4u*)(dst + row * D + cbase + 128 * bj) = pk8(a, b); } }
        } else {
            const bool isq = tile < 12; const int hbase = 2 * (tile - (isq ? 10 : 12));
            const int half = wc >> 1, i0b = ((cc0 & 63) >> 1);
            float lg[2][2];
#pragma unroll
            for (int bj = 0; bj < 2; ++bj)
#pragma unroll
                for (int d = 0; d < 2; ++d) lg[bj][d] = *(LAS const float*)(tab + TAB_LG + (d * 4 + hbase + bj) * 4);
            const float sgn = isq ? 1.f : -1.f, scl = isq ? 1.f : 0.08838834764831845f;
#pragma unroll
            for (int ai = 0; ai < 2; ++ai) {
                f32x4 cs01[4], cs23[4];
#pragma unroll
                for (int m = 0; m < 4; ++m) { cs01[m] = (f32x4){1.f, 0.f, 1.f, 0.f}; cs23[m] = (f32x4){1.f, 0.f, 1.f, 0.f};
                    if (!isctx) { const size_t row = (size_t)u.pm * 256 + ai * 128 + wr * 64 + 4 * fr + m; const int pos = half == 0 ? (int)((row & 2047) >> 6) : (4 * fr + m); LAS const unsigned char* rp = tab + ((pos & 3) * 16 + (pos >> 2)) * 272 + i0b * 8;
                        cs01[m] = *(LAS const f32x4*)rp; cs23[m] = *(LAS const f32x4*)(rp + 16); } }
#pragma unroll
                for (int m = 0; m < 4; ++m) {
                    const size_t row = (size_t)u.pm * 256 + ai * 128 + wr * 64 + 4 * fr + m; const int ic = 4 * fr + m;
                    const f32x4 c01 = cs01[m], c23 = cs23[m];
#pragma unroll
                    for (int bj = 0; bj < 2; ++bj) {
                        const f32x4 a = acc[ai][bj][m][0] * scl, b = acc[ai][bj][m][1] * scl; f32x4 ra, rb;
                        ra.x = a.x * c01.x - a.y * c01.y; ra.y = a.x * c01.y + a.y * c01.x; ra.z = a.z * c01.z - a.w * c01.w; ra.w = a.z * c01.w + a.w * c01.z;
                        rb.x = b.x * c23.x - b.y * c23.y; rb.y = b.x * c23.y + b.y * c23.x; rb.z = b.z * c23.z - b.w * c23.w; rb.w = b.z * c23.w + b.w * c23.z;
                        const float ef = __expf(sgn * (float)(ic + 1) * lg[bj][0]), eb = __expf(sgn * (float)(64 - ic) * lg[bj][1]);
                        const size_t o = row * D + 512 + (hbase + bj) * 128 + cc0;
                        if (isq) { *(v4u*)(qf + o) = pk8(ra * ef, rb * ef); *(v4u*)(qb + o) = pk8(ra * eb, rb * eb); }
                        else { *(v4u*)(kf + o) = pk8(ra * ef, rb * ef); *(v4u*)(kb + o) = pk8(ra * eb, rb * eb); }
                    }
                }
            }
        }
    }
};
struct InOrder {
    pg8::StaticOrder so; int G, c;
    __device__ void init(int G_, int c_) { so.init(M, NIN, G_, c_); G = G_; c = c_; }
    __device__ bool next(int i, Unit& u) const {
        const long Li = (long)i * G + c;
        if (Li < 2304) return so.next(i, u);
        const int r = (int)(Li - 2304); if (r >= 192) return false;
        u.pm = 128 + r / 12; const int q = r % 12; u.pn = q < 8 ? q : q + 4; return true;
    }
    __device__ __forceinline__ void a_ready(const Unit&) const {}
    __device__ __forceinline__ void done(const Unit&) const {}
};


__device__ __forceinline__ void edge_phase(Frame& F) {
    const int gw = F.vcu * NWAVES + F.wave, NGW = F.G * NWAVES;
    const float* EG = (const float*)(F.ws + WS_EDGEG); const float* EU = (const float*)(F.ws + WS_EDGEU); bf16* hid = (bf16*)(F.ws + WS_HID);
    for (int it = gw; it < 1024 * 11; it += NGW) {
        const int er = it / 11, q = it % 11, blk = er >> 1, e2 = er & 1, c = 256 * q + 4 * F.lane;
        const int row = 64 * blk + (e2 ? 63 : 0), t = row % L;
        f32x4 prev, cur, next; const f32x4 z = {0.f, 0.f, 0.f, 0.f};
        if (e2 == 0) { prev = t == 0 ? z : __builtin_nontemporal_load((const f32x4*)(EG + ((size_t)(blk - 1) * 4 + 3) * DFF + c)); cur = __builtin_nontemporal_load((const f32x4*)(EG + ((size_t)blk * 4 + 0) * DFF + c)); next = __builtin_nontemporal_load((const f32x4*)(EG + ((size_t)blk * 4 + 1) * DFF + c)); }
        else { prev = __builtin_nontemporal_load((const f32x4*)(EG + ((size_t)blk * 4 + 2) * DFF + c)); cur = __builtin_nontemporal_load((const f32x4*)(EG + ((size_t)blk * 4 + 3) * DFF + c)); next = t == L - 1 ? z : __builtin_nontemporal_load((const f32x4*)(EG + ((size_t)(blk + 1) * 4 + 0) * DFF + c)); }
        const f32x4 up = __builtin_nontemporal_load((const f32x4*)(EU + ((size_t)blk * 2 + e2) * DFF + c));
        const f32x4 cw0 = *(const f32x4*)(F.conv_w + c), cw1 = *(const f32x4*)(F.conv_w + DFF + c), cw2 = *(const f32x4*)(F.conv_w + 2 * DFF + c), cbv = *(const f32x4*)(F.conv_b + c);
        const f32x4 gt = cw0 * prev + cw1 * cur + cw2 * next + cbv;
        v2u w; w.x = pk2(siluf(gt.x) * up.x, siluf(gt.y) * up.y); w.y = pk2(siluf(gt.z) * up.z, siluf(gt.w) * up.w);
        *(v2u*)(hid + (size_t)row * DFF + c) = w;
    }
}

namespace mx {
typedef float f32x16 __attribute__((ext_vector_type(16)));
typedef float f32x8 __attribute__((ext_vector_type(8)));
typedef __bf16 bf8 __attribute__((ext_vector_type(8)));
typedef short s16x4 __attribute__((ext_vector_type(4)));
typedef short s16x8 __attribute__((ext_vector_type(8)));
#define MX_MFMA(a, b, c) __builtin_amdgcn_mfma_f32_32x32x16_bf16((a), (b), (c), 0, 0, 0)
constexpr int MX_NT = 2;
constexpr int IMG = 16384, BUFB = 3 * IMG, NBUF = 2, EXI_OFF = NBUF * BUFB, GTI_OFF = EXI_OFF + IMG, SSQ_OFF = GTI_OFF + IMG, DVEC_OFF = SSQ_OFF + 1024, GN_OFF = DVEC_OFF + 2048;
__device__ __forceinline__ unsigned off_b(unsigned row, unsigned ch) { return 256u * row + 16u * (ch ^ (((row & 3u) << 2) | ((row >> 2) & 3u))); }
__device__ __forceinline__ int crow(int reg, int h) { return (reg & 3) + 8 * (reg >> 2) + 4 * h; }
__device__ __forceinline__ s16x8 pack_step(const f32x16& x, int s) { f32x8 t;
#pragma unroll
    for (int i = 0; i < 8; ++i) t[i] = x[8 * s + i];
    return __builtin_bit_cast(s16x8, __builtin_convertvector(t, bf8)); }
typedef float f32x2v __attribute__((ext_vector_type(2)));
typedef __bf16 bf2v __attribute__((ext_vector_type(2)));
__device__ __forceinline__ unsigned cvt2(float lo, float hi) { f32x2v t = {lo, hi}; return __builtin_bit_cast(unsigned, __builtin_convertvector(t, bf2v)); }
__device__ __forceinline__ s16x8 row_read(LAS unsigned char* img, unsigned row, unsigned ch) { return *(LAS s16x8*)(img + off_b(row, ch)); }
__device__ __forceinline__ s16x4 tr4(LAS unsigned char* p) { return __builtin_amdgcn_ds_read_tr16_b64_v4i16((LAS s16x4*)p); }
__device__ __forceinline__ s16x8 cat8(s16x4 lo, s16x4 hi) { return __builtin_shufflevector(lo, hi, 0, 1, 2, 3, 4, 5, 6, 7); }

__device__ __forceinline__ void stage_chunk(LAS unsigned char* buf, const bf16* q, const bf16* k, const bf16* v, size_t row0, int col0, int narr, int iw, int lane) {
    const int per = narr * 4;
    asm volatile("" : "+v"(lane));
    for (int qi = 0; qi < per; ++qi) {
        const int idx = iw * per + qi, a = idx >> 4, i = idx & 15, arr = a + (3 - narr);
        const bf16* base = arr == 0 ? q : (arr == 1 ? k : v);
        const unsigned rl = 4 * i + (lane >> 4), pos = lane & 15, ch = pos ^ (((rl & 3u) << 2) | ((rl >> 2) & 3u));
        const bf16* src = base + (row0 + rl) * (size_t)D + col0 + 8 * ch;
        __builtin_amdgcn_global_load_lds((const unsigned*)src, (LAS unsigned*)(buf + arr * IMG + i * 1024), 16, 0, MX_NT);
    }
}

#define MX_SB() __builtin_amdgcn_sched_barrier(0)
template <bool FWD>
__device__ __forceinline__ void chunk_out(LAS unsigned char* buf, const f32x16 (&S)[4], f32x16 (&o)[2], int w, int lane) {
    LAS unsigned char* qimg = buf; LAS unsigned char* kimg = buf + IMG; LAS unsigned char* vimg = buf + 2 * IMG;
    const unsigned r = lane & 31, h = lane >> 5, blk = (lane >> 4) & 1, q4 = (lane & 15) >> 2, p = lane & 3;
#pragma unroll
    for (int i = 0; i < 16; ++i) { o[0][i] = 0.f; o[1][i] = 0.f; }
    s16x4 qf[2][4][4];
#pragma unroll
    for (int bt = 0; bt < 2; ++bt)
#pragma unroll
        for (int gi = 0; gi < 4; ++gi) { const int g = 4 * bt + gi, kb = g >> 1, st = g & 1;
#pragma unroll
            for (int tt = 0; tt < 2; ++tt)
#pragma unroll
                for (int e = 0; e < 2; ++e) qf[bt][gi][2 * tt + e] = *(LAS s16x4*)(qimg + off_b(32 * tt + r, 4 * kb + 2 * st + e) + 8 * h); }
    MX_SB();
    s16x8 fa[2][4][2];
#define MX_LOADP(bf, TILE, HALF) do { const int st_ = FWD ? ((TILE) == 2 ? 1 : 0) : ((TILE) == 0 ? 0 : 1), tt_ = FWD ? ((TILE) == 0 ? 0 : 1) : ((TILE) == 2 ? 1 : 0); \
        _Pragma("unroll") for (int j = 0; j < 4; ++j) { const int ks = 4 * (HALF) + j; fa[bf][j][0] = row_read(kimg, 32 * st_ + r, 2 * ks + h); fa[bf][j][1] = row_read(qimg, 32 * tt_ + r, 2 * ks + h); } } while (0)
#pragma unroll
    for (int gi = 0; gi < 4; ++gi) { const int kb = gi >> 1, st = gi & 1; const s16x8 xs = pack_step(S[kb], st);
        o[0] = MX_MFMA(xs, cat8(qf[0][gi][0], qf[0][gi][1]), o[0]); o[1] = MX_MFMA(xs, cat8(qf[0][gi][2], qf[0][gi][3]), o[1]); }
    MX_SB(); MX_LOADP(0, 0, 0); MX_SB();
#pragma unroll
    for (int gi = 0; gi < 4; ++gi) { const int g = 4 + gi, kb = g >> 1, st = g & 1; const s16x8 xs = pack_step(S[kb], st);
        o[0] = MX_MFMA(xs, cat8(qf[1][gi][0], qf[1][gi][1]), o[0]); o[1] = MX_MFMA(xs, cat8(qf[1][gi][2], qf[1][gi][3]), o[1]); }
    MX_SB();
#pragma unroll
    for (int tile = 0; tile < 3; ++tile) {
        const int st = FWD ? (tile == 2 ? 1 : 0) : (tile == 0 ? 0 : 1), tt = FWD ? (tile == 0 ? 0 : 1) : (tile == 2 ? 1 : 0);
        f32x16 X;
#pragma unroll
        for (int i = 0; i < 16; ++i) X[i] = 0.f;
        MX_LOADP(1, tile, 1);
        s16x4 vf[2][2];
#pragma unroll
        for (int sp = 0; sp < 2; ++sp) { const unsigned R0 = 32 * st + 16 * sp + 4 * h + q4, chv = 4 * w + 2 * blk + (p >> 1);
            vf[sp][0] = tr4(vimg + off_b(R0, chv) + 8 * (p & 1)); vf[sp][1] = tr4(vimg + off_b(R0 + 8, chv) + 8 * (p & 1)); }
        MX_SB();
#pragma unroll
        for (int j = 0; j < 4; ++j) X = MX_MFMA(fa[0][j][0], fa[0][j][1], X);
        MX_SB();
        if (tile < 2) { MX_LOADP(0, tile + 1, 0); }
        MX_SB();
#pragma unroll
        for (int j = 0; j < 4; ++j) X = MX_MFMA(fa[1][j][0], fa[1][j][1], X);
        if (st == tt) {
#pragma unroll
            for (int i = 0; i < 16; ++i) { const int sl = crow(i, h); const bool keep = FWD ? ((int)r >= sl) : ((int)r <= sl); X[i] = keep ? X[i] : 0.f; }
        }
#pragma unroll
        for (int sp = 0; sp < 2; ++sp) o[tt] = MX_MFMA(cat8(vf[sp][0], vf[sp][1]), pack_step(X, sp), o[tt]);
        MX_SB();
    }
#undef MX_LOADP
}
__device__ __forceinline__ void chunk_state(LAS unsigned char* buf, const LAS float* dvec, bool cdec, float gam64, f32x16 (&S)[4], int w, int lane) {
    LAS unsigned char* kimg = buf + IMG; LAS unsigned char* vimg = buf + 2 * IMG;
    const unsigned h = lane >> 5, blk = (lane >> 4) & 1, q4 = (lane & 15) >> 2, p = lane & 3;
    s16x4 fs[2][5][2];
#define MX_LOADS(bf, KS) do { const unsigned R0 = 16 * (KS) + 8 * h + q4, chv = 4 * w + 2 * blk + (p >> 1); \
        fs[bf][0][0] = tr4(vimg + off_b(R0, chv) + 8 * (p & 1)); fs[bf][0][1] = tr4(vimg + off_b(R0 + 4, chv) + 8 * (p & 1)); \
        _Pragma("unroll") for (int kb = 0; kb < 4; ++kb) { const unsigned chk = 4 * kb + 2 * blk + (p >> 1); \
            fs[bf][1 + kb][0] = tr4(kimg + off_b(R0, chk) + 8 * (p & 1)); fs[bf][1 + kb][1] = tr4(kimg + off_b(R0 + 4, chk) + 8 * (p & 1)); } } while (0)
    MX_LOADS(0, 0); MX_SB();
#pragma unroll
    for (int ks = 0; ks < 4; ++ks) {
        if (ks < 3) { if ((ks & 1) == 0) MX_LOADS(1, ks + 1); else MX_LOADS(0, ks + 1); }
        MX_SB();
        const s16x8 bfrag = cat8(fs[ks & 1][0][0], fs[ks & 1][0][1]);
#pragma unroll
        for (int kb = 0; kb < 4; ++kb) S[kb] = MX_MFMA(cat8(fs[ks & 1][1 + kb][0], fs[ks & 1][1 + kb][1]), bfrag, S[kb]);
        MX_SB();
    }
#undef MX_LOADS
    if (cdec) {
#pragma unroll
        for (int kb = 0; kb < 4; ++kb)
#pragma unroll
            for (int i = 0; i < 16; ++i) S[kb][i] *= gam64;
    } else {
#pragma unroll
        for (int kb = 0; kb < 4; ++kb)
#pragma unroll
            for (int g = 0; g < 4; ++g) { const f32x4 dv = *(const LAS f32x4*)(dvec + 32 * kb + 8 * g + 4 * h);
                S[kb][4 * g + 0] *= dv.x; S[kb][4 * g + 1] *= dv.y; S[kb][4 * g + 2] *= dv.z; S[kb][4 * g + 3] *= dv.w; }
    }
}

__device__ __forceinline__ size_t chunk_row0(int s, int b, int dir) { return s < 4 ? (size_t)M + (size_t)b * CL + 64 * (dir == 0 ? s : 3 - s) : (size_t)b * L + 64 * (dir == 0 ? s - 4 : 31 - (s - 4)); }
__device__ __forceinline__ void stage_img(LAS unsigned char* dst, const bf16* base, size_t row0, int col0, int iw, int lane) {
    asm volatile("" : "+v"(lane));
    for (int qi = 0; qi < 4; ++qi) { const int i = iw * 4 + qi; const unsigned rl = 4 * i + (lane >> 4), pos = lane & 15, ch = pos ^ (((rl & 3u) << 2) | ((rl >> 2) & 3u));
        __builtin_amdgcn_global_load_lds((const unsigned*)(base + (row0 + rl) * (size_t)D + col0 + 8 * ch), (LAS unsigned*)(dst + i * 1024), 16, 0, MX_NT); }
}
__device__ __forceinline__ void stage_all(LAS unsigned char* lds, LAS float* dv0, const bf16* q, const bf16* k, const bf16* v, int sn, size_t rn, int col0, bool isret, const float* darr, int hh, int wave, int lane) {
    stage_chunk(lds + (sn & 1) * BUFB, q, k, v, rn, col0, sn >= 4 ? 3 : 2, wave - 4, lane);
    if (wave == 4 && !isret) __builtin_amdgcn_global_load_lds((const unsigned*)(darr + (rn >> 6) * 512 + hh * 128 + 4 * lane), (LAS unsigned*)(dv0 + (sn & 1) * 256), 16, 0, MX_NT);
}
__device__ __forceinline__ void st8_async(const void* p, v2u v) { asm volatile("global_store_dwordx2 %0, %1, off\n\ts_nop 1" :: "v"(p), "v"(v) : "memory"); }
struct MixIO { const bf16 *qf, *kf, *qb, *kb, *v; const bf16* gmix; bf16* mixout; size_t mixmask; const float *df, *db; bf16* ex; };

struct MixCtx { volatile LAS unsigned* misc; LAS unsigned char* lds; LAS float* ssqx; LAS float* dv0; const bf16* qarr; const bf16* karr; const float* darr; const LAS float* gnl; float gam64; int b, dir, hh, col0, wave, lane; bool isret, cw; };
template <int MODE>
__device__ __forceinline__ void io_step(const MixIO& io, const MixCtx& c, int s) {
    const size_t r0 = chunk_row0(s, c.b, c.dir);
    VM_WAIT();
    __builtin_amdgcn_s_barrier(); asm volatile("" ::: "memory");
    if (MODE == 2) { stage_img(c.lds + EXI_OFF, io.ex, r0, c.col0, c.wave - 4, c.lane); stage_img(c.lds + GTI_OFF, io.gmix, r0, c.col0, c.wave - 4, c.lane); }
    if (s + 1 < 36) stage_all(c.lds, c.dv0, c.qarr, c.karr, io.v, s + 1, chunk_row0(s + 1, c.b, c.dir), c.col0, c.isret, c.darr, c.hh, c.wave, c.lane);
    if (MODE == 2) {
        const int nfly = (s + 1 < 36) ? ((c.wave == 4 && !c.isret) ? 13 : 12) : 0;
        if (nfly == 13) asm volatile("s_waitcnt vmcnt(13)" ::: "memory"); else if (nfly == 12) asm volatile("s_waitcnt vmcnt(12)" ::: "memory"); else VM_WAIT();
        __builtin_amdgcn_s_barrier(); asm volatile("" ::: "memory");
        __builtin_amdgcn_s_barrier(); asm volatile("" ::: "memory");
    }
}
template <bool FWD, int MODE>
__device__ __forceinline__ void compute_step(const MixIO& io, const MixCtx& c, f32x16 (&S)[4], int s) {
    const size_t r0 = chunk_row0(s, c.b, c.dir);
    LAS unsigned char* eximg = c.lds + EXI_OFF; LAS unsigned char* gtimg = c.lds + GTI_OFF;
    LDS_WAIT(); __builtin_amdgcn_s_barrier(); asm volatile("" ::: "memory");
    int lane = c.lane; asm volatile("" : "+v"(lane));
    LAS unsigned char* buf = c.lds + (s & 1) * BUFB; const int w = c.wave; const LAS float* dvec = c.dv0 + (s & 1) * 256;
    if (MODE == 0) { chunk_state(buf, dvec, c.isret, c.gam64, S, w, lane); return; }
    f32x16 o[2];
    chunk_out<FWD>(buf, S, o, w, lane);
    const unsigned r = lane & 31, h = lane >> 5; const int col0 = c.col0;
    if (MODE == 1) {
#pragma unroll
        for (int tt = 0; tt < 2; ++tt)
#pragma unroll
            for (int g = 0; g < 4; ++g) { v2u wv; wv.x = cvt2(o[tt][4 * g], o[tt][4 * g + 1]); wv.y = cvt2(o[tt][4 * g + 2], o[tt][4 * g + 3]); st8_async(io.ex + (r0 + 32 * tt + r) * D + col0 + 32 * w + 8 * g + 4 * h, wv); }
        chunk_state(buf, dvec, c.isret, c.gam64, S, w, lane);
    } else {
        chunk_state(buf, dvec, c.isret, c.gam64, S, w, lane);
        LDS_WAIT(); __builtin_amdgcn_s_barrier(); asm volatile("" ::: "memory");
        asm volatile("" : "+v"(lane));
        v2u gt[2][4];
#pragma unroll
        for (int tt = 0; tt < 2; ++tt) { float ssq = 0.f;
#pragma unroll
            for (int g = 0; g < 4; ++g) { const unsigned a = off_b(32 * tt + (lane & 31), 4 * w + g) + 8 * (lane >> 5); const v2u oth = *(const LAS v2u*)(eximg + a); gt[tt][g] = *(const LAS v2u*)(gtimg + a);
                float y0 = o[tt][4 * g] + bf2f(oth.x & 0xffff), y1 = o[tt][4 * g + 1] + bf2f(oth.x >> 16), y2 = o[tt][4 * g + 2] + bf2f(oth.y & 0xffff), y3 = o[tt][4 * g + 3] + bf2f(oth.y >> 16);
                if (!c.isret) { y0 *= bf2f(gt[tt][g].x & 0xffff); y1 *= bf2f(gt[tt][g].x >> 16); y2 *= bf2f(gt[tt][g].y & 0xffff); y3 *= bf2f(gt[tt][g].y >> 16); }
                o[tt][4 * g] = y0; o[tt][4 * g + 1] = y1; o[tt][4 * g + 2] = y2; o[tt][4 * g + 3] = y3; ssq += (y0 * y0 + y1 * y1) + (y2 * y2 + y3 * y3); }
            ssq += __shfl_xor(ssq, 32);
            if (h == 0) c.ssqx[w * 64 + 32 * tt + r] = ssq; }
        LDS_WAIT(); __builtin_amdgcn_s_barrier(); asm volatile("" ::: "memory");
#pragma unroll
        for (int tt = 0; tt < 2; ++tt) { const int t = 32 * tt + r; const float tot = (c.ssqx[t] + c.ssqx[64 + t]) + (c.ssqx[128 + t] + c.ssqx[192 + t]); const float rstd = rsqrtf(tot * (1.f / 128.f) + EPS);
#pragma unroll
            for (int g = 0; g < 4; ++g) { const f32x4 gn = *(const LAS f32x4*)(c.gnl + 32 * w + 8 * g + 4 * h);
                float y0 = o[tt][4 * g] * rstd * gn.x, y1 = o[tt][4 * g + 1] * rstd * gn.y, y2 = o[tt][4 * g + 2] * rstd * gn.z, y3 = o[tt][4 * g + 3] * rstd * gn.w;
                if (c.isret) { y0 *= bf2f(gt[tt][g].x & 0xffff); y1 *= bf2f(gt[tt][g].x >> 16); y2 *= bf2f(gt[tt][g].y & 0xffff); y3 *= bf2f(gt[tt][g].y >> 16); }
                v2u wv; wv.x = cvt2(y0, y1); wv.y = cvt2(y2, y3);
                st8_async(io.mixout + (((r0 + t) * D + col0 + 32 * w + 8 * g + 4 * h) & io.mixmask), wv); } }
    }
}
template <bool FWD>
__device__ __forceinline__ void mixer_run(const MixIO& io, const MixCtx& c, const XcdBarrier& gbar) {
#define MSTAMP(i) do { if (EXP_TA >= 0 && ((i) == EXP_TA || (i) == EXP_TB) && blockIdx.x == 0 && threadIdx.x == 0) c.misc[16 + ((i) == EXP_TB ? 1 : 0)] = (unsigned)__builtin_amdgcn_s_memrealtime(); } while (0)
    if (c.cw) {
        f32x16 S[4];
#pragma unroll
        for (int kb = 0; kb < 4; ++kb)
#pragma unroll
            for (int i = 0; i < 16; ++i) S[kb][i] = 0.f;
        MSTAMP(40);
        for (int s = 0; s < 4; ++s) compute_step<FWD, 0>(io, c, S, s);
        MSTAMP(41);
        for (int s = 4; s < 20; ++s) compute_step<FWD, 1>(io, c, S, s);
        MSTAMP(42);
        xcd_barrier(gbar);
        MSTAMP(43);
        for (int s = 20; s < 36; ++s) compute_step<FWD, 2>(io, c, S, s);
        MSTAMP(44);
    } else {
        stage_all(c.lds, c.dv0, c.qarr, c.karr, io.v, 0, chunk_row0(0, c.b, c.dir), c.col0, c.isret, c.darr, c.hh, c.wave, c.lane);
        for (int s = 0; s < 4; ++s) io_step<0>(io, c, s);
        for (int s = 4; s < 20; ++s) io_step<1>(io, c, s);
        xcd_barrier(gbar);
        for (int s = 20; s < 36; ++s) io_step<2>(io, c, s);
    }
}
__device__ __forceinline__ void mixer_phase(Frame& F, const MixIO& io, const XcdBarrier& gbar) {
    const int scan = F.vcu; MixCtx c;
    c.dir = scan & 1; const int head = (scan >> 1) & 7; c.b = scan >> 4; c.isret = head >= 4; c.hh = head & 3; c.col0 = head * 128;
    c.misc = F.MISC; c.lds = F.lds; c.ssqx = (LAS float*)(F.lds + SSQ_OFF); c.dv0 = (LAS float*)(F.lds + DVEC_OFF);
    c.qarr = c.dir == 0 ? io.qf : io.qb; c.karr = c.dir == 0 ? io.kf : io.kb; c.darr = c.dir == 0 ? io.df : io.db;
    c.gam64 = c.isret ? expf(-64.f * log1pf(expf(-F.ret_decay[c.dir * 4 + c.hh]))) : 0.f;
    { LAS float* gl = (LAS float*)(F.lds + GN_OFF); if (F.tid < 128) gl[F.tid] = ((c.isret ? F.ret_norm_g : F.hgrn_norm_g) + c.hh * 128)[F.tid]; c.gnl = gl; }
    c.wave = F.wave; c.lane = F.lane; c.cw = F.wave < 4;
    if (c.dir == 0) mixer_run<true>(io, c, gbar); else mixer_run<false>(io, c, gbar);
}
}


struct Args { const float* in[19]; float* out; unsigned char* ws; int ph_lo, ph_hi, li, pad; };
__global__ void __launch_bounds__(NWAVES * 64, 2) mk_fwd(Args args) {
    extern __shared__ __attribute__((aligned(16))) unsigned char lds[];
    Frame F;
    F.lds = (LAS unsigned char*)lds;
    F.MISC = (volatile LAS unsigned*)(F.lds + MISC_OFF);
    F.tid = threadIdx.x; F.lane = F.tid & 63; F.wave = __builtin_amdgcn_readfirstlane(F.tid >> 6);
    F.G = gridDim.x; { const int bx = blockIdx.x; F.vcu = (F.G % 8 == 0) ? (bx % 8) * (F.G / 8) + bx / 8 : bx; }
    F.ws = args.ws; F.ctl = (gu32*)(args.ws + WS_CTL);
    F.x = args.in[0]; F.c = args.in[1]; F.ctx = args.in[2]; F.c_ctx = args.in[3]; F.w_mod = args.in[4]; F.b_mod = args.in[5]; F.norm1_g = args.in[6]; F.w_in = args.in[7];
    F.hgrn_lb = args.in[8]; F.hgrn_norm_g = args.in[9]; F.ret_decay = args.in[10]; F.ret_norm_g = args.in[11]; F.w_out = args.in[12]; F.norm2_g = args.in[13]; F.w_up = args.in[14];
    F.conv_w = args.in[15]; F.conv_b = args.in[16]; F.w_down = args.in[17]; F.final_g = args.in[18]; F.out = args.out;
    for (int u = F.tid; u < (LDS_BYTES - LDSCTL_OFF) / 4; u += NWAVES * 64) ((LAS unsigned*)(F.lds + LDSCTL_OFF))[u] = 0u;
    __syncthreads();
    XcdBarrier bar = xcd_barrier_post((unsigned*)(F.ctl + CW_BAR) + args.li * XCD_BAR_WORDS, F.MISC + 8);
    const int lo = args.ph_lo, hi = args.ph_hi;
#define IN(k) (lo <= (k) && (k) < hi)
#define BOTH(k) (IN(k) && IN((k) + 1))
    const float* MOD = (const float*)(F.ws + WS_MOD);

    STAMP(0);
    REFRESH_IDS();
    if (IN(0)) { p0_prologue(F); }
    STAMP(1);
    REFRESH_IDS();
    if (IN(1)) { mod_wait(F); p0b_phase(F, (bf16*)F.out); if (BOTH(1)) xcd_barrier(bar); }
    STAMP(2);
    REFRESH_IDS();
    if (IN(2)) {
        pg8::Gemm g{(const pg8::bf16_t*)F.out, (const pg8::bf16_t*)(F.ws + WS_WIN), MT, NIN, D}; InOrder S; S.init(F.G, (int)blockIdx.x);
        p1_tables(F);
        EpiIn E{F.ws, F.lds + RING_BYTES};
        pg8::gemm_phase<EpiIn, InOrder, true, true>(F.lds + RING_OFF, g, S, E, F.wave);
        late_transposes(F);
        if (BOTH(2)) xcd_barrier(bar);
    }
    STAMP(3);
    REFRESH_IDS();
    if (IN(3)) {
        mx::MixIO io{(const bf16*)(F.ws + WS_QF), (const bf16*)(F.ws + WS_KF), (const bf16*)(F.ws + WS_QB), (const bf16*)(F.ws + WS_KB), (const bf16*)(F.ws + WS_V), (bf16*)(F.ws + WS_G),
                     (bf16*)(F.ws + WS_G), ~(size_t)0, (const float*)(F.ws + WS_DF), (const float*)(F.ws + WS_DB), (bf16*)F.out};
        bias2_phase(F);
        mx::mixer_phase(F, io, bar);
        if (IN(5)) xcd_barrier(bar);
    }
    STAMP(5);
    REFRESH_IDS();
    if (IN(5)) {
        pg8::Gemm g{(const pg8::bf16_t*)(F.ws + WS_MIXED), (const pg8::bf16_t*)(F.ws + WS_WOUT), M, D, D}; pg8::StaticOrder S; S.init(M, D, F.G, (int)blockIdx.x);
        EpiOut E{F.x, (bf16*)(F.ws + WS_X1B), (bf16*)(F.ws + WS_A2), MOD, F.norm2_g, (float*)(F.ws + WS_SSQ1)};
        pg8::gemm_phase<EpiOut, pg8::StaticOrder, true, true>(F.lds + RING_OFF, g, S, E, F.wave);
        if (BOTH(5)) xcd_barrier(bar);
    }
    STAMP(6);
    REFRESH_IDS();
    if (IN(6)) {
        pg8::Gemm g{(const pg8::bf16_t*)(F.ws + WS_A2), (const pg8::bf16_t*)(F.ws + WS_WUP), M, DUP, D}; pg8::StaticOrder S; S.init(M, DUP, F.G, (int)blockIdx.x);
        EpiUp E{(const float*)(F.ws + WS_SSQ1), (const float*)(F.ws + WS_BIAS2), F.conv_w, F.conv_b, (bf16*)(F.ws + WS_HID), (float*)(F.ws + WS_EDGEG), (float*)(F.ws + WS_EDGEU)};
        pg8::gemm_phase<EpiUp, pg8::StaticOrder, true, true>(F.lds + RING_OFF, g, S, E, F.wave);
        if (BOTH(6)) xcd_barrier(bar);
    }
    STAMP(7);
    REFRESH_IDS();
    if (IN(7)) { edge_phase(F); if (BOTH(7)) xcd_barrier(bar); }
    STAMP(8);
    REFRESH_IDS();
    if (IN(8)) {
        pg8::Gemm g{(const pg8::bf16_t*)(F.ws + WS_HID), (const pg8::bf16_t*)(F.ws + WS_WDN), M, D, DFF}; pg8::StaticOrder S; S.init(M, D, F.G, (int)blockIdx.x);
        EpiDownNorm E{(const bf16*)(F.ws + WS_X1B), F.out, MOD, F.final_g, (float*)(F.ws + WS_XBUF), (unsigned*)(F.ctl + CW_PANEL), F.lds + RING_BYTES};
        pg8::gemm_phase<EpiDownNorm, pg8::StaticOrder, true, true>(F.lds + RING_OFF, g, S, E, F.wave);
    }
    STAMP(9);
    STAMP(10);
    if (EXP_TA >= 0 && blockIdx.x == 0 && threadIdx.x == 0) { const unsigned dt = (F.MISC[17] - F.MISC[16]) * (unsigned)EXP_AMP; const unsigned long long t0 = __builtin_amdgcn_s_memrealtime();
        while ((unsigned)(__builtin_amdgcn_s_memrealtime() - t0) < dt) __builtin_amdgcn_s_sleep(8); }
#undef IN
#undef BOTH
}


static int mk_grid() {
    static int grid = 0;
    if (grid == 0) {
        int dev = 0, cus = 0, per_cu = 0;
        if (hipGetDevice(&dev) != hipSuccess || hipDeviceGetAttribute(&cus, hipDeviceAttributeMultiprocessorCount, dev) != hipSuccess) { fprintf(stderr, "kernel_launch: device query failed\n"); grid = -1; return grid; }
        if (hipFuncSetAttribute((const void*)mk_fwd, hipFuncAttributeMaxDynamicSharedMemorySize, LDS_BYTES) != hipSuccess) { fprintf(stderr, "kernel_launch: hipFuncSetAttribute failed\n"); grid = -1; return grid; }
        if (hipOccupancyMaxActiveBlocksPerMultiprocessor(&per_cu, (const void*)mk_fwd, NWAVES * 64, LDS_BYTES) != hipSuccess || per_cu < 1) { fprintf(stderr, "kernel_launch: occupancy query reports %d blocks per CU\n", per_cu); (void)hipGetLastError(); grid = -1; return grid; }
        grid = cus;
    }
    return grid;
}
static void mk_launch(const Args& a0, int lo, int hi, int li, int grid, hipStream_t stream) {
    Args a = a0; a.ph_lo = lo; a.ph_hi = hi; a.li = li; a.pad = 0;
    hipLaunchKernelGGL(mk_fwd, dim3(grid), dim3(NWAVES * 64), LDS_BYTES, stream, a);
}
extern "C" void kernel_launch(void* const* d_in, const int* in_sizes, int n_in, void* d_out, int out_size, void* d_ws, size_t ws_size, hipStream_t stream) {
    const int grid = mk_grid(); if (grid < 0) return;
    if (n_in != 19 || out_size != M * D || ws_size < WS_END) { fprintf(stderr, "kernel_launch: unexpected shapes\n"); return; }
    (void)hipMemsetAsync((char*)d_ws + WS_CTL, 0, CTL_ZERO_BYTES, stream);
    Args a{}; for (int i = 0; i < 19; ++i) a.in[i] = (const float*)d_in[i]; a.out = (float*)d_out; a.ws = (unsigned char*)d_ws;
    mk_launch(a, 0, 10, 0, grid, stream);
}
```

```cpp
#include <hip/hip_runtime.h>
#include <cstdio>
#include <cstdint>
#ifndef EXP_TA
#define EXP_TA -1
#endif
#ifndef EXP_TB
#define EXP_TB -1
#endif
#ifndef EXP_TPH
#define EXP_TPH -1
#endif
#define PG8_STAMP(i) do { if (EXP_TA >= 60 && Epi::STAMP_PH == EXP_TPH && ((i) == EXP_TA || (i) == EXP_TB) && blockIdx.x == 0 && tid == 0) ((volatile PG8_LAS unsigned*)(lds + (163840 - 1024 + 320) + 64))[(i) == EXP_TB ? 1 : 0] = (unsigned)__builtin_amdgcn_s_memrealtime(); } while (0)
__device__ __forceinline__ int cur_lane() { int l_; asm volatile("v_mbcnt_lo_u32_b32 %0, -1, 0\n\tv_mbcnt_hi_u32_b32 %0, -1, %0" : "=v"(l_)); return l_; }
namespace pg8 {
#define PG8_LAS __attribute__((address_space(3)))
typedef unsigned short bf16_t;
typedef short bf16x8 __attribute__((ext_vector_type(8)));
typedef float f32x4 __attribute__((ext_vector_type(4)));
typedef unsigned u32x4 __attribute__((ext_vector_type(4)));
constexpr int BM = 256, BK = 64, HALF = 128, HTB = HALF * BK * 2  , STAGE_BYTES = 8 * HTB, NXCD = 8, WGM = 8;

__host__ __device__ __forceinline__ int lds_byte(int r, int c) { const int st = (r >> 4) * 2 + (c >> 5), rr = r & 15, cc = c & 31, ob = rr * 64 + cc * 2; return st * 1024 + (ob ^ (((ob >> 9) & 1) << 5)); }
__host__ __device__ __forceinline__ void stage_rc(int b, int& R, int& C) { const int st = b / 1024, sb = b % 1024, swz = sb ^ (((sb >> 9) & 1) << 5); R = (st >> 1) * 16 + swz / 64; C = (st & 1) * 32 + (swz % 64) / 2; }
__host__ __device__ __forceinline__ int aperm64(int p) { return 4 * (p & 15) + (p >> 4); }
__host__ __device__ __forceinline__ int perm32(int rho) { const int n = rho >> 4, i = rho & 15; return 8 * (i >> 2) + 4 * n + (i & 3); }

struct Unit { int pm, pn; };
struct Gemm { const bf16_t* A; const bf16_t* Bt; int M, N, K; };

struct StaticOrder {
    int nM, nN, nwg, G, c;
    __host__ __device__ void init(int M, int N, int G_, int c_) { nM = M / BM; nN = N / BM; nwg = nM * nN; G = G_; c = c_; }
    __host__ __device__ bool next(int i, Unit& u) const {
        const long L = (long)i * G + c; if (L >= nwg) return false;
        int wgid = (int)L; { const int q = nwg / NXCD, r = nwg % NXCD, xcd = wgid % NXCD, off = wgid / NXCD; wgid = (xcd < r ? xcd * (q + 1) : r * (q + 1) + (xcd - r) * q) + off; }
        const int nig = WGM * nN, gid = wgid / nig, fm = gid * WGM, gsz = (nM - fm) < WGM ? (nM - fm) : WGM;
        u.pm = fm + ((wgid % nig) % gsz); u.pn = (wgid % nig) / gsz; return true;
    }
    __device__ __forceinline__ void a_ready(const Unit&) const {}
    __device__ __forceinline__ void done(const Unit&) const {}
};

__device__ __forceinline__ unsigned cvt_pk_bf16(float lo, float hi) { unsigned r; asm volatile("v_cvt_pk_bf16_f32 %0, %1, %2" : "=v"(r) : "v"(lo), "v"(hi)); return r; }

template <class Epi, class Sched, bool ALIGN_EPI = false, bool SP2 = false>
__device__ __forceinline__ void gemm_phase(PG8_LAS unsigned char* lds, const Gemm g, const Sched& S, const Epi& E, const int wave_in) {
    int lane_raw_ = cur_lane();
    const int lane = lane_raw_, wid = wave_in, tid = wid * 64 + lane, wr = wid >> 2, wc = wid & 3, fr = lane & 15, fq = lane >> 4;
    const int K = g.K, nt = K / BK;
    unsigned voffA[2], voffB[2];
#pragma unroll
    for (int i = 0; i < 2; ++i) { int R, C; stage_rc(tid * 16 + i * 8192, R, C); const int Rb = Epi::PERM ? ((R & ~31) + perm32(R & 31)) : R;
        const int Ra = Epi::APERM ? ((R & ~63) + aperm64(R & 63)) : R;
        voffA[i] = (unsigned)(Ra * K + C) * 2u; voffB[i] = (unsigned)(Rb * K + C) * 2u; }
    const size_t kstep = (size_t)(BK * 2);
    const size_t hstep = (size_t)HALF * K * 2;
    const size_t tstep = 2 * hstep;
    const unsigned ldsw = (unsigned)wid * 1024u;
    const int aoff = lds_byte(wr * 64 + fr, fq * 8), boff = lds_byte(wc * 32 + fr, fq * 8);
#define PG8_SA(b, h) (((b) * 2 + (h)) * HTB)
#define PG8_SB(b, h) ((4 + (b) * 2 + (h)) * HTB)
#define PG8_STAGE(bufoff, gbase, voff) do { _Pragma("unroll") for (int _i = 0; _i < 2; ++_i) \
        __builtin_amdgcn_global_load_lds((const unsigned*)((const char*)(gbase) + (voff)[_i]), (PG8_LAS unsigned*)(lds + (bufoff) + ldsw + _i * 8192), 16, 0, 0); } while (0)
#define PG8_LDA(dst, b, h) do { _Pragma("unroll") for (int m = 0; m < 4; ++m) _Pragma("unroll") for (int k = 0; k < 2; ++k) dst[m][k] = *(const PG8_LAS bf16x8*)(lds + PG8_SA(b, h) + aoff + m * 2048 + k * 1024); } while (0)
#define PG8_LDB(dst, b, h) do { _Pragma("unroll") for (int n = 0; n < 2; ++n) _Pragma("unroll") for (int k = 0; k < 2; ++k) dst[n][k] = *(const PG8_LAS bf16x8*)(lds + PG8_SB(b, h) + boff + n * 2048 + k * 1024); } while (0)
#define PG8_MMA(ai, bj, At, Bt) do { __builtin_amdgcn_s_setprio(1); _Pragma("unroll") for (int m = 0; m < 4; ++m) _Pragma("unroll") for (int n = 0; n < 2; ++n) _Pragma("unroll") for (int k = 0; k < 2; ++k) \
        acc[ai][bj][m][n] = __builtin_amdgcn_mfma_f32_16x16x32_bf16(Bt[n][k], At[m][k], acc[ai][bj][m][n], 0, 0, 0); __builtin_amdgcn_s_setprio(0); } while (0)
#define PG8_WAIT_V(n) asm volatile("s_waitcnt vmcnt(" #n ")" ::: "memory")
#define PG8_WAIT_L(n) asm volatile("s_waitcnt lgkmcnt(" #n ")" ::: "memory")
#define PG8_BAR __builtin_amdgcn_s_barrier()
#define PG8_SCHED __builtin_amdgcn_sched_barrier(0)
    Unit cur, nxt; int ui = 0;
    if (!S.next(0, cur)) return;
    f32x4 acc[2][2][4][2];
    bf16x8 At[4][2], B0[2][2], B1[2][2];
    const char* cA = (const char*)g.A + (size_t)cur.pm * tstep; const char* cB = (const char*)g.Bt + (size_t)cur.pn * tstep;
    S.a_ready(cur);
    if constexpr (SP2) {
        if constexpr (Epi::FASTPRO) {
        PG8_STAGE(PG8_SB(0, 0), cB, voffB); PG8_SCHED; PG8_STAGE(PG8_SB(0, 1), cB + hstep, voffB); PG8_SCHED; PG8_STAGE(PG8_SA(0, 0), cA, voffA); PG8_SCHED; PG8_STAGE(PG8_SA(0, 1), cA + hstep, voffA); PG8_SCHED;
        PG8_STAGE(PG8_SB(1, 0), cB + kstep, voffB); PG8_SCHED; PG8_STAGE(PG8_SA(1, 0), cA + kstep, voffA); PG8_SCHED; PG8_STAGE(PG8_SB(1, 1), cB + hstep + kstep, voffB); PG8_SCHED;
        if constexpr (Epi::PRO_HOOK) E.pro_hook(tid);
        if (wr == 1) PG8_BAR;
        PG8_WAIT_V(8); PG8_BAR;
        PG8_WAIT_V(6); PG8_BAR;
        } else {
        PG8_STAGE(PG8_SB(0, 0), cB, voffB); PG8_STAGE(PG8_SB(0, 1), cB + hstep, voffB); PG8_STAGE(PG8_SA(0, 0), cA, voffA); PG8_STAGE(PG8_SA(0, 1), cA + hstep, voffA);
        if (wr == 1) PG8_BAR;
        PG8_WAIT_V(2); PG8_BAR;
        PG8_STAGE(PG8_SB(1, 0), cB + kstep, voffB); PG8_STAGE(PG8_SA(1, 0), cA + kstep, voffA); PG8_STAGE(PG8_SB(1, 1), cB + hstep + kstep, voffB);
        PG8_WAIT_V(6); PG8_BAR;
        }
    } else {
        PG8_STAGE(PG8_SB(0, 0), cB, voffB); PG8_STAGE(PG8_SA(0, 0), cA, voffA); PG8_STAGE(PG8_SB(0, 1), cB + hstep, voffB); PG8_STAGE(PG8_SA(0, 1), cA + hstep, voffA);
        if (wr == 1) PG8_BAR;
        PG8_WAIT_V(4); PG8_BAR;
        PG8_STAGE(PG8_SB(1, 0), cB + kstep, voffB); PG8_STAGE(PG8_SA(1, 0), cA + kstep, voffA); PG8_STAGE(PG8_SB(1, 1), cB + hstep + kstep, voffB);
        PG8_WAIT_V(6); PG8_BAR;
    }
    PG8_SCHED;
#pragma unroll
    for (int a = 0; a < 2; ++a)
#pragma unroll
        for (int b = 0; b < 2; ++b)
#pragma unroll
            for (int m = 0; m < 4; ++m)
#pragma unroll
                for (int n = 0; n < 2; ++n) acc[a][b][m][n] = (f32x4){0.f, 0.f, 0.f, 0.f};
    for (;;) {
        const bool has_next = S.next(ui + 1, nxt);
        const char* nA = has_next ? (const char*)g.A + (size_t)nxt.pm * tstep : cA; const char* nB = has_next ? (const char*)g.Bt + (size_t)nxt.pn * tstep : cB;
        for (int t = 0; t < nt; t += 2) {
            const bool last = (t == nt - 2);
            const char* a1 = cA + (size_t)(t + 1) * kstep;
            const char* a2 = last ? nA : cA + (size_t)(t + 2) * kstep; const char* b2 = last ? nB : cB + (size_t)(t + 2) * kstep;
            const char* a3 = a2 + kstep; const char* b3 = b2 + kstep;
            if (last && has_next) S.a_ready(nxt);
            if constexpr (SP2) {
            PG8_LDB(B0, 0, 0); PG8_LDB(B1, 0, 1); PG8_SCHED; PG8_LDA(At, 0, 0); PG8_STAGE(PG8_SA(1, 1), a1 + hstep, voffA);
            PG8_WAIT_V(8); PG8_WAIT_L(0); PG8_BAR; PG8_MMA(0, 0, At, B0); PG8_MMA(0, 1, At, B1); PG8_BAR; PG8_SCHED;
            PG8_LDA(At, 0, 1); PG8_STAGE(PG8_SB(0, 0), b2, voffB); PG8_STAGE(PG8_SB(0, 1), b2 + hstep, voffB); PG8_STAGE(PG8_SA(0, 0), a2, voffA);
            PG8_WAIT_V(8); PG8_WAIT_L(0); PG8_BAR; PG8_MMA(1, 0, At, B0); PG8_MMA(1, 1, At, B1); PG8_BAR; PG8_SCHED;
            PG8_LDB(B0, 1, 0); PG8_LDB(B1, 1, 1); PG8_SCHED; PG8_LDA(At, 1, 0); PG8_STAGE(PG8_SA(0, 1), a2 + hstep, voffA);
            PG8_WAIT_V(8); PG8_WAIT_L(0); PG8_BAR; PG8_MMA(0, 0, At, B0); PG8_MMA(0, 1, At, B1); PG8_BAR; PG8_SCHED;
            PG8_LDA(At, 1, 1); PG8_STAGE(PG8_SB(1, 0), b3, voffB); PG8_STAGE(PG8_SB(1, 1), b3 + hstep, voffB); PG8_STAGE(PG8_SA(1, 0), a3, voffA);
            PG8_WAIT_V(8); PG8_WAIT_L(0); PG8_BAR; PG8_MMA(1, 0, At, B0); PG8_MMA(1, 1, At, B1); PG8_BAR; PG8_SCHED;
            } else {
            PG8_LDB(B0, 0, 0); PG8_SCHED; PG8_LDA(At, 0, 0); PG8_STAGE(PG8_SA(1, 1), a1 + hstep, voffA);
            PG8_WAIT_L(8); PG8_BAR; PG8_WAIT_L(0); PG8_MMA(0, 0, At, B0); PG8_BAR; PG8_SCHED;
            PG8_LDB(B1, 0, 1); PG8_STAGE(PG8_SB(0, 0), b2, voffB);
            PG8_BAR; PG8_WAIT_L(0); PG8_MMA(0, 1, At, B1); PG8_BAR;
            PG8_LDA(At, 0, 1); PG8_STAGE(PG8_SA(0, 0), a2, voffA);
            PG8_BAR; PG8_WAIT_L(0); PG8_MMA(1, 0, At, B0); PG8_BAR; PG8_SCHED;
            PG8_STAGE(PG8_SB(0, 1), b2 + hstep, voffB);
            PG8_WAIT_V(6); PG8_BAR; PG8_MMA(1, 1, At, B1); PG8_BAR;
            PG8_LDB(B0, 1, 0); PG8_SCHED; PG8_LDA(At, 1, 0); PG8_STAGE(PG8_SA(0, 1), a2 + hstep, voffA);
            PG8_WAIT_L(8); PG8_BAR; PG8_WAIT_L(0); PG8_MMA(0, 0, At, B0); PG8_BAR; PG8_SCHED;
            PG8_LDB(B1, 1, 1); PG8_STAGE(PG8_SB(1, 0), b3, voffB);
            PG8_BAR; PG8_WAIT_L(0); PG8_MMA(0, 1, At, B1); PG8_BAR;
            PG8_LDA(At, 1, 1); PG8_STAGE(PG8_SA(1, 0), a3, voffA);
            PG8_BAR; PG8_WAIT_L(0); PG8_MMA(1, 0, At, B0); PG8_BAR; PG8_SCHED;
            PG8_STAGE(PG8_SB(1, 1), b3 + hstep, voffB);
            PG8_WAIT_V(6); PG8_BAR; PG8_MMA(1, 1, At, B1); PG8_BAR;
            }
        }
        if constexpr (ALIGN_EPI) { if (wr == 0) PG8_BAR; }
        PG8_STAMP(60 + 2 * ui);
        if constexpr (!Epi::AFTER_DRAIN) { E(acc, cur, wr, wc, fr, fq); S.done(cur); }
        PG8_STAMP(61 + 2 * ui);
        if (!has_next) break;
#pragma unroll
        for (int a = 0; a < 2; ++a)
#pragma unroll
            for (int b = 0; b < 2; ++b)
#pragma unroll
                for (int m = 0; m < 4; ++m)
#pragma unroll
                    for (int n = 0; n < 2; ++n) acc[a][b][m][n] = (f32x4){0.f, 0.f, 0.f, 0.f};
        cur = nxt; cA = nA; cB = nB; ++ui;
        if constexpr (ALIGN_EPI) { if (wr == 1) PG8_BAR; }
    }
    PG8_WAIT_V(0);
    if constexpr (!ALIGN_EPI) { if (wr == 0) PG8_BAR; }
    PG8_BAR;
    if constexpr (Epi::AFTER_DRAIN) { E.fused(acc, cur, wr, wc, fr, fq, lds, wid, lane); S.done(cur); }
#undef PG8_SA
#undef PG8_SB
#undef PG8_STAGE
#undef PG8_LDA
#undef PG8_LDB
#undef PG8_MMA
#undef PG8_WAIT_V
#undef PG8_WAIT_L
#undef PG8_BAR
#undef PG8_SCHED
}

}

constexpr int NWAVES = 8;
constexpr int D = 1024, NBATCH = 16, L = 2048, CL = 256, M = NBATCH * L, MC = NBATCH * CL, MT = M + MC, NIN = 4608, DFF = 2816, DUP = 5632;
constexpr float EPS = 1e-6f;
constexpr int N_PHASES = 10;
constexpr int MAX_LAUNCH = 4;
#ifndef EXP_TA
#define EXP_TA -1
#endif
#ifndef EXP_TB
#define EXP_TB -1
#endif
#ifndef EXP_AMP
#define EXP_AMP 4
#endif
#define STAMP(i) do { if (EXP_TA >= 0 && ((i) == EXP_TA || (i) == EXP_TB) && blockIdx.x == 0 && threadIdx.x == 0) F.MISC[16 + ((i) == EXP_TB ? 1 : 0)] = (unsigned)__builtin_amdgcn_s_memrealtime(); } while (0)

constexpr size_t MiB = 1u << 20;
constexpr size_t WS_CTL = 0, CTL_ZERO_BYTES = 64 * 1024;
constexpr size_t WS_MOD = 1 * MiB;
constexpr size_t WS_BIAS2 = 1 * MiB + 512 * 1024;
constexpr size_t WS_ROPE = 2 * MiB;
constexpr size_t WS_WIN = 3 * MiB, WS_WOUT = 12 * MiB, WS_WUP = 14 * MiB, WS_WDN = 25 * MiB;
constexpr size_t WS_DF = 31 * MiB, WS_DB = 32 * MiB + 512 * 1024;
constexpr size_t WS_SSQ1 = 34 * MiB;
constexpr size_t WS_EDGEG = 36 * MiB;
constexpr size_t WS_EDGEU = 58 * MiB;
constexpr size_t WS_XBUF = 70 * MiB;
constexpr size_t SKEW = 68 * 1024;
constexpr size_t WS_KF = 72 * MiB, WS_KB = 145 * MiB + 1 * SKEW, WS_V = 218 * MiB + 2 * SKEW;
constexpr size_t WS_QF = 291 * MiB + 3 * SKEW, WS_QB = 356 * MiB + 4 * SKEW, WS_G = 421 * MiB + 5 * SKEW;
constexpr size_t WS_MIXED = WS_G, WS_A2 = WS_QF, WS_X1B = WS_QB, WS_HID = WS_KF;
constexpr size_t WS_END = 486 * MiB;
constexpr int CW_BAR = 4096, CW_MODCNT = 2048, CW_PANEL = 8192;

constexpr int RING_OFF = 0, RING_BYTES = 131072;
constexpr int LDS_BYTES = 163840;
constexpr int LDSCTL_OFF = LDS_BYTES - 1024, MISC_OFF = LDSCTL_OFF + 320;

#define GAS __attribute__((address_space(1)))
#define LAS __attribute__((address_space(3)))
typedef unsigned short bf16;
typedef unsigned v4u __attribute__((ext_vector_type(4)));
typedef unsigned v2u __attribute__((ext_vector_type(2)));
typedef float f32x4 __attribute__((ext_vector_type(4)));
typedef short bf16x8 __attribute__((ext_vector_type(8)));
typedef GAS unsigned gu32;
#define RLX_AGENT __ATOMIC_RELAXED, __HIP_MEMORY_SCOPE_AGENT
#define LDS_WAIT() asm volatile("s_waitcnt lgkmcnt(0)" ::: "memory")
#define VM_WAIT() asm volatile("s_waitcnt vmcnt(0)" ::: "memory")
__device__ __forceinline__ unsigned f2bf(float f) { unsigned u = __builtin_bit_cast(unsigned, f); return (u + 0x7fffu + ((u >> 16) & 1u)) >> 16; }
__device__ __forceinline__ unsigned pk2(float lo, float hi) { return f2bf(lo) | (f2bf(hi) << 16); }
__device__ __forceinline__ float bf2f(unsigned short h) { return __builtin_bit_cast(float, (unsigned)h << 16); }
__device__ __forceinline__ float sigm(float x) { return __builtin_amdgcn_rcpf(1.f + __expf(-x)); }
__device__ __forceinline__ float siluf(float x) { return x * __builtin_amdgcn_rcpf(1.f + __expf(-x)); }

#define XB_TMO      128
#define XB_XCNT(j)  (256  + 64 * (j))
#define XB_XSUB(j)  (1280 + 64 * (j))
#define XB_XGEN(j)  (2304 + 64 * (j))
#define XB_TOP      3328
#define XB_TOPGEN   3392
#define XCD_BAR_WORDS 3456
#define XB_SPIN_CAP (1u << 18)

__device__ __forceinline__ unsigned xb_ld(unsigned* p)              { return __hip_atomic_load(p, __ATOMIC_RELAXED, __HIP_MEMORY_SCOPE_AGENT); }
__device__ __forceinline__ unsigned xb_add(unsigned* p, unsigned v) { return __hip_atomic_fetch_add(p, v, __ATOMIC_RELAXED, __HIP_MEMORY_SCOPE_AGENT); }
__device__ __forceinline__ unsigned xb_xcc_id() { return (unsigned)__builtin_amdgcn_s_getreg((3 << 11) | 20) & 0xFu; }
#define XB_SPIN(cond, bar) do { unsigned _sp = 0; while (cond) { __builtin_amdgcn_s_sleep(1); \
    if ((++_sp & 255u) == 0u) { if (xb_ld(&(bar)[XB_TMO])) break; if (_sp > XB_SPIN_CAP) { atomicAdd(&(bar)[XB_TMO], 1u); break; } } } } while (0)

struct XcdBarrier {
    unsigned* bar; unsigned x; int wave;
    volatile LAS unsigned* st;
};

__device__ __forceinline__ XcdBarrier xcd_barrier_post(unsigned* bar, volatile LAS unsigned* st) {
    XcdBarrier b; b.bar = bar; b.x = xb_xcc_id(); b.st = st; b.wave = __builtin_amdgcn_readfirstlane((int)threadIdx.x >> 6);
    if (threadIdx.x == 0) (void)xb_add(&bar[XB_XCNT(b.x)], 1u);
    return b;
}
__device__ __forceinline__ void xcd_barrier_complete(unsigned* bar, unsigned x, unsigned& nloc, unsigned& nx) {
    const unsigned G = gridDim.x * gridDim.y * gridDim.z;
    unsigned sum, cnt, mine, sp = 0u;
    for (;;) {
        sum = 0u; cnt = 0u; mine = 0u;
#pragma unroll
        for (unsigned j = 0; j < 16; ++j) { const unsigned c = xb_ld(&bar[XB_XCNT(j)]); sum += c; cnt += (c > 0u) ? 1u : 0u; mine = (j == x) ? c : mine; }
        if (sum == G) break;
        __builtin_amdgcn_s_sleep(1);
        if ((++sp & 255u) == 0u) { if (xb_ld(&bar[XB_TMO])) break; if (sp > XB_SPIN_CAP) { atomicAdd(&bar[XB_TMO], 1u); break; } }
    }
    nloc = mine > 0u ? mine : 1u; nx = cnt > 0u ? cnt : 1u;
}

__device__ __forceinline__ void xcd_barrier(const XcdBarrier& b) {
    asm volatile("s_waitcnt vmcnt(0)" ::: "memory");
    __syncthreads();
    if (b.wave == 0 && cur_lane() == 0) {
        unsigned* bar = b.bar;
        __builtin_amdgcn_s_waitcnt(0);
        unsigned nloc = b.st[0], nx = b.st[1];
        if (nloc == 0u) { xcd_barrier_complete(bar, b.x, nloc, nx); b.st[0] = nloc; b.st[1] = nx; }
        const unsigned old = xb_add(&bar[XB_XSUB(b.x)], 1u);
        const unsigned gen = old / nloc;
        if (old + 1u == (gen + 1u) * nloc) {
            __builtin_amdgcn_fence(__ATOMIC_RELEASE, "agent");
            asm volatile("s_waitcnt vmcnt(0)" ::: "memory");
            const unsigned og = xb_add(&bar[XB_TOP], 1u);
            const unsigned tg = og / nx;
            if (og + 1u == (tg + 1u) * nx) xb_add(&bar[XB_TOPGEN], 1u);
            else XB_SPIN(xb_ld(&bar[XB_TOPGEN]) == tg, bar);
            __builtin_amdgcn_fence(__ATOMIC_ACQUIRE, "agent");
            xb_add(&bar[XB_XGEN(b.x)], 1u);
            asm volatile("s_waitcnt vmcnt(0)" ::: "memory");
        } else {
            XB_SPIN(xb_ld(&bar[XB_XGEN(b.x)]) == gen, bar);
            __builtin_amdgcn_fence(__ATOMIC_ACQUIRE, "agent");
            asm volatile("s_waitcnt vmcnt(0)" ::: "memory");
        }
    }
    __syncthreads();
}


struct Frame {
    LAS unsigned char* lds;
    volatile LAS unsigned* MISC;
    gu32* ctl;
    int tid, lane, wave;
    int vcu, G;
    unsigned char* ws;
    const float *x, *c, *ctx, *c_ctx, *w_mod, *b_mod, *norm1_g, *w_in, *hgrn_lb, *hgrn_norm_g, *ret_decay, *ret_norm_g, *w_out, *norm2_g, *w_up, *conv_w, *conv_b, *w_down, *final_g;
    float* out;
};
#define REFRESH_IDS() do { int l_ = cur_lane(); asm volatile("" : "+v"(l_)); F.lane = l_; F.tid = F.wave * 64 + l_; } while (0)
__device__ __forceinline__ float xsum16(float x) { const unsigned u_ = __builtin_bit_cast(unsigned, x); unsigned w_; asm volatile("v_mov_b32 %0, %1" : "=v"(w_) : "v"(u_));
    const v2u r = __builtin_amdgcn_permlane16_swap(u_, w_, false, false); unsigned a_ = r.x, b_ = r.y; asm volatile("" : "+v"(a_), "+v"(b_));
    return __builtin_bit_cast(float, a_) + __builtin_bit_cast(float, b_); }
__device__ __forceinline__ float xsum32(float x) { const unsigned u_ = __builtin_bit_cast(unsigned, x); unsigned w_; asm volatile("v_mov_b32 %0, %1" : "=v"(w_) : "v"(u_));
    const v2u r = __builtin_amdgcn_permlane32_swap(u_, w_, false, false); unsigned a_ = r.x, b_ = r.y; asm volatile("" : "+v"(a_), "+v"(b_));
    return __builtin_bit_cast(float, a_) + __builtin_bit_cast(float, b_); }
template <int CTRL> __device__ __forceinline__ float dpp0(float x) { return __builtin_bit_cast(float, __builtin_amdgcn_update_dpp(0, __builtin_bit_cast(int, x), CTRL, 0xF, 0xF, false)); }
__device__ __forceinline__ float wave_sum(float v) {
    v += dpp0<0xB1>(v); v += dpp0<0x4E>(v);
    v += dpp0<0x124>(v); v += dpp0<0x128>(v);
    return xsum32(xsum16(v));
}

__device__ __forceinline__ int ropeperm(int p) { const int half = p >> 6, pp = p & 63; return 64 * half + (pp >> 1) + 32 * (pp & 1); }
__device__ __forceinline__ int win_colmap(int phys) {
    const int tile = phys >> 8, c = phys & 255;
    if (tile < 8) {
        const int h = tile >> 1, kh = tile & 1, bj = c >> 7, cc = c & 127, jp = cc >> 3, n = (cc >> 2) & 1, i = cc & 3, key = 64 * kh + 4 * jp + i;
        const int grp = bj == 0 ? (n == 0 ? 0 : 1024) : (n == 0 ? 1536 : 512);
        return grp + h * 128 + key;
    }
    if (tile < 10) return 2048 + (tile - 8) * 256 + c;
    if (tile < 12) return 2560 + (2 * (tile - 10) + (c >> 7)) * 128 + ropeperm(c & 127);
    if (tile < 14) return 3072 + (2 * (tile - 12) + (c >> 7)) * 128 + ropeperm(c & 127);
    if (tile < 16) return 3584 + (tile - 14) * 256 + c;
    return 4096 + (tile - 16) * 256 + c;
}
__device__ __forceinline__ int wup_colmap(int phys) { const int j = phys >> 8, c = phys & 255; return c < 128 ? 128 * j + c : DFF + 128 * j + (c - 128); }
__device__ __forceinline__ int win_inv(int col) {
    const int grp = col >> 9, hcol = col & 511, h = hcol >> 7, key = hcol & 127;
    if (grp <= 3) { const int tile = 2 * h + (key >> 6), kk = key & 63, jp = kk >> 2, i = kk & 3;
        const int sub = grp == 0 ? 0 : (grp == 2 ? 4 : (grp == 3 ? 128 : 132));
        return 256 * tile + sub + 8 * jp + i; }
    if (grp == 5 || grp == 6) { const int half = key >> 6, l6 = key & 63, pp = 2 * (l6 & 31) + (l6 >> 5); return col - key + 64 * half + pp; }
    return col;
}
__device__ __forceinline__ int wup_inv(int col) { return col < DFF ? 256 * (col >> 7) + (col & 127) : 256 * ((col - DFF) >> 7) + 128 + ((col - DFF) & 127); }

struct TrItem { const float* W; bf16* WT; int K, N, map, item; };
constexpr int TR_I_IN = (D / 64) * (NIN / 32), TR_I_ALL = TR_I_IN + (D / 64) * (D / 32) + (D / 64) * (DUP / 32) + (DFF / 64) * (D / 32);
__device__ __forceinline__ bool tr_item(const Frame& F, int it, TrItem& t) {
    constexpr int I_IN = (D / 64) * (NIN / 32), I_O = (D / 64) * (D / 32), I_UP = (D / 64) * (DUP / 32), I_DN = (DFF / 64) * (D / 32);
    int r = it;
    if (r < I_IN) { t = TrItem{F.w_in, (bf16*)(F.ws + WS_WIN), D, NIN, 1, r}; return true; } r -= I_IN;
    if (r < I_O) { t = TrItem{F.w_out, (bf16*)(F.ws + WS_WOUT), D, D, 0, r}; return true; } r -= I_O;
    if (r < I_UP) { t = TrItem{F.w_up, (bf16*)(F.ws + WS_WUP), D, DUP, 2, r}; return true; } r -= I_UP;
    if (r < I_DN) { t = TrItem{F.w_down, (bf16*)(F.ws + WS_WDN), DFF, D, 0, r}; return true; }
    return false;
}
__device__ __forceinline__ void tr_load(const TrItem& t, f32x4 (&v)[8], int lane) {
    const int nblk = t.N / 32, kb = t.item / nblk, nb = t.item % nblk, k0 = 64 * kb, n0 = 32 * nb;
    const float* src = t.W + (size_t)(k0 + (lane >> 3)) * t.N + n0 + 4 * (lane & 7);
#pragma unroll
    for (int i = 0; i < 8; ++i) v[i] = __builtin_nontemporal_load((const f32x4*)(src + (size_t)(8 * i) * t.N));
}
__device__ __forceinline__ void tr_store(const TrItem& t, const f32x4 (&v)[8], LAS float* scr, int lane) {
    const int nblk = t.N / 32, kb = t.item / nblk, nb = t.item % nblk, k0 = 64 * kb, n0 = 32 * nb;
#pragma unroll
    for (int i = 0; i < 8; ++i) { LAS float* d = scr + (8 * i + (lane >> 3)) * 33 + 4 * (lane & 7); d[0] = v[i].x; d[1] = v[i].y; d[2] = v[i].z; d[3] = v[i].w; }
    LDS_WAIT(); asm volatile("" ::: "memory");
    const int c = lane & 7;
#pragma unroll
    for (int j = 0; j < 4; ++j) { const int n = (lane >> 3) + 8 * j, nl = n0 + n, nphys = t.map == 0 ? nl : (t.map == 1 ? win_inv(nl) : wup_inv(nl)); const LAS float* s = scr + (8 * c) * 33 + n;
        v4u o; o.x = pk2(s[0 * 33], s[1 * 33]); o.y = pk2(s[2 * 33], s[3 * 33]); o.z = pk2(s[4 * 33], s[5 * 33]); o.w = pk2(s[6 * 33], s[7 * 33]);
        *(GAS v4u*)(t.WT + (size_t)nphys * t.K + k0 + 8 * c) = o; }
    LDS_WAIT(); asm volatile("" ::: "memory");
}

__device__ __forceinline__ void p0_mod(Frame& F, int cg) {
    LAS float* scr = (LAS float*)(F.lds) + F.wave * (128 * 20);
    LAS float* red = (LAS float*)(F.lds + 8 * 128 * 20 * 4);
    float* MOD = (float*)(F.ws + WS_MOD);
    const int k0 = F.wave * 128, kh = F.lane >> 5, col = F.lane & 31;
    const float* wp = F.w_mod + (size_t)(k0 + kh) * 6144 + cg * 32 + col;
    float w[32];
#pragma unroll
    for (int i = 0; i < 32; ++i) w[i] = __builtin_nontemporal_load(wp + (size_t)(2 * i) * 6144);
    {
        float cv[34];
#pragma unroll
        for (int q = 0; q < 34; ++q) { const int r = q >> 1, kk = F.lane + 64 * (q & 1); cv[q] = r < 16 ? F.c[r * D + k0 + kk] : F.c_ctx[k0 + kk]; }
#pragma unroll
        for (int q = 0; q < 34; ++q) { const int r = q >> 1, kk = F.lane + 64 * (q & 1); scr[kk * 20 + r] = cv[q] / (1.f + __expf(-cv[q])); }
    }
    LDS_WAIT(); asm volatile("" ::: "memory");
    float acc[17];
#pragma unroll
    for (int r = 0; r < 17; ++r) acc[r] = 0.f;
#pragma nounroll
    for (int i0 = 0; i0 < 64; i0 += 32) {
#pragma unroll
        for (int i = 0; i < 32; ++i) {
            const LAS float* sp = scr + (2 * (i0 + i) + kh) * 20; const float wv = w[i];
            const f32x4 a0 = *(const LAS f32x4*)sp, a1 = *(const LAS f32x4*)(sp + 4), a2 = *(const LAS f32x4*)(sp + 8), a3 = *(const LAS f32x4*)(sp + 12); const float a4 = sp[16];
            acc[0] += a0.x * wv; acc[1] += a0.y * wv; acc[2] += a0.z * wv; acc[3] += a0.w * wv; acc[4] += a1.x * wv; acc[5] += a1.y * wv; acc[6] += a1.z * wv; acc[7] += a1.w * wv;
            acc[8] += a2.x * wv; acc[9] += a2.y * wv; acc[10] += a2.z * wv; acc[11] += a2.w * wv; acc[12] += a3.x * wv; acc[13] += a3.y * wv; acc[14] += a3.z * wv; acc[15] += a3.w * wv; acc[16] += a4 * wv; }
        if (i0 == 0) {
#pragma unroll
            for (int i = 0; i < 32; ++i) w[i] = __builtin_nontemporal_load(wp + (size_t)(2 * (32 + i)) * 6144);
        }
    }
#pragma unroll
    for (int r = 0; r < 17; ++r) { acc[r] = xsum32(acc[r]); if (kh == 0) red[(F.wave * 17 + r) * 32 + col] = acc[r]; }
    __syncthreads();
    for (int o = F.tid; o < 17 * 32; o += NWAVES * 64) { const int r = o >> 5, cc = o & 31; float s = F.b_mod[cg * 32 + cc];
#pragma unroll
        for (int ww = 0; ww < 8; ++ww) s += red[(ww * 17 + r) * 32 + cc];
        __hip_atomic_store(MOD + (size_t)r * 6144 + cg * 32 + cc, s, __ATOMIC_RELAXED, __HIP_MEMORY_SCOPE_AGENT); }
    asm volatile("s_waitcnt vmcnt(0)" ::: "memory");
    __syncthreads();
    if (F.tid == 0) __hip_atomic_fetch_add((unsigned*)(F.ctl + CW_MODCNT), 1u, __ATOMIC_RELAXED, __HIP_MEMORY_SCOPE_AGENT);
}
__device__ __forceinline__ void mod_wait(Frame& F) {
    if (F.tid == 0) {
        unsigned sp = 0;
        while (__hip_atomic_load((unsigned*)(F.ctl + CW_MODCNT), __ATOMIC_RELAXED, __HIP_MEMORY_SCOPE_AGENT) < 192u) { __builtin_amdgcn_s_sleep(2); if (++sp > (1u << 22)) break; }
        __builtin_amdgcn_fence(__ATOMIC_ACQUIRE, "agent");
        asm volatile("s_waitcnt vmcnt(0)" ::: "memory");
    }
    __syncthreads();
}

__device__ __forceinline__ void p0_prologue(Frame& F) {
    STAMP(20); if (F.vcu < 192) p0_mod(F, F.vcu); STAMP(21);
    if (F.vcu == 192) {
        float2* T = (float2*)(F.ws + WS_ROPE);
        for (int e = F.tid; e < 64 * 32; e += NWAVES * 64) { const int pos = e >> 5, i = e & 31; const float ang = (float)pos * powf(10000.f, -(float)i / 32.f); T[e] = make_float2(cosf(ang), sinf(ang)); }
    }
    {
        const int gw = F.vcu * NWAVES + F.wave, NGW = F.G * NWAVES;
        LAS float* scr = (LAS float*)(F.lds + RING_OFF + F.wave * 16384);
        for (int it = NGW - 1 - gw; it < TR_I_IN; it += 2 * NGW) {
            TrItem t0, t1; f32x4 v0[8], v1[8]; const bool h0 = tr_item(F, it, t0), h1 = (it + NGW) < TR_I_IN && tr_item(F, it + NGW, t1);
            if (h0) tr_load(t0, v0, F.lane); if (h1) tr_load(t1, v1, F.lane);
            if (h0) tr_store(t0, v0, scr, F.lane); if (h1) tr_store(t1, v1, scr, F.lane);
        }
    }
    STAMP(22);
}

__device__ __forceinline__ void p1_tables(Frame& F) {
    LAS unsigned char* tab = F.lds + RING_BYTES;
    const unsigned char* rope = F.ws + WS_ROPE;
    for (int ch = F.tid; ch < 1024; ch += NWAVES * 64) { const int pos = ch >> 4; *(LAS f32x4*)(tab + ((pos & 3) * 16 + (pos >> 2)) * 272 + (ch & 15) * 16) = *(const f32x4*)(rope + ch * 16); }
    { const int t = F.tid; const float a0f = F.hgrn_lb[t], a1f = F.hgrn_lb[512 + t], a0b = F.hgrn_lb[1024 + t], a1b = F.hgrn_lb[1536 + t];
      *(LAS float*)(tab + 64 * 272 + t * 4) = __builtin_amdgcn_rcpf(1.f + __expf(a1f - a0f)); *(LAS float*)(tab + 64 * 272 + 2048 + t * 4) = __builtin_amdgcn_rcpf(1.f + __expf(a1b - a0b));
      if (t < 8) *(LAS float*)(tab + 64 * 272 + 4096 + t * 4) = -log1pf(expf(-F.ret_decay[t])); }
    __syncthreads();
}
__device__ __forceinline__ void late_transposes(Frame& F) {
    const int bx = (int)blockIdx.x; const bool part = F.G == 256; if (part && bx < 192) return;
    const int nw = part ? 64 * NWAVES : F.G * NWAVES, iw = part ? (bx - 192) * NWAVES + F.wave : bx * NWAVES + F.wave;
    LAS float* scr = (LAS float*)(F.lds + RING_OFF + F.wave * 16384);
    for (int it = TR_I_IN + iw; it < TR_I_ALL; it += 2 * nw) {
        TrItem t0, t1; f32x4 v0[8], v1[8]; const bool h0 = tr_item(F, it, t0), h1 = (it + nw) < TR_I_ALL && tr_item(F, it + nw, t1);
        if (h0) tr_load(t0, v0, F.lane); if (h1) tr_load(t1, v1, F.lane);
        if (h0) tr_store(t0, v0, scr, F.lane); if (h1) tr_store(t1, v1, scr, F.lane);
    }
}

__device__ __forceinline__ void bias2_phase(Frame& F) {
    const float* MOD = (const float*)(F.ws + WS_MOD);
    {
        typedef float f32x4a __attribute__((ext_vector_type(4)));
        typedef __bf16 bf8v __attribute__((ext_vector_type(8)));
        typedef float f32x8v __attribute__((ext_vector_type(8)));
        const bf16* WUP = (const bf16*)(F.ws + WS_WUP); float* B2 = (float*)(F.ws + WS_BIAS2);
        LAS f32x4a* red = (LAS f32x4a*)(F.lds);
        for (int t = F.vcu; t < DUP / 16; t += F.G) {
            const int bl = F.lane & 15, kq = F.lane >> 4;
            f32x4a acc = {0.f, 0.f, 0.f, 0.f};
#pragma unroll
            for (int ks = 0; ks < 4; ++ks) {
                const int k = 128 * F.wave + 32 * ks + 8 * kq;
                const f32x4a p = *(const f32x4a*)(MOD + (size_t)bl * 6144 + 3072 + k), q = *(const f32x4a*)(MOD + (size_t)bl * 6144 + 3072 + k + 4);
                f32x8v pq; pq[0] = p.x; pq[1] = p.y; pq[2] = p.z; pq[3] = p.w; pq[4] = q.x; pq[5] = q.y; pq[6] = q.z; pq[7] = q.w;
                const bf16x8 af = __builtin_bit_cast(bf16x8, __builtin_convertvector(pq, bf8v));
                const bf16x8 bfr = *(const GAS bf16x8*)(WUP + (size_t)(16 * t + bl) * D + k);
                acc = __builtin_amdgcn_mfma_f32_16x16x32_bf16(af, bfr, acc, 0, 0, 0);
            }
            red[F.wave * 64 + F.lane] = acc;
            __syncthreads();
            if (F.wave == 0) { f32x4a sum = red[F.lane];
#pragma unroll
                for (int w = 1; w < 8; ++w) sum += red[w * 64 + F.lane];
#pragma unroll
                for (int rg = 0; rg < 4; ++rg) B2[(size_t)(4 * kq + rg) * DUP + 16 * t + bl] = sum[rg]; }
            __syncthreads();
        }
    }
}

constexpr int P0B_RPI = 3;
__device__ __forceinline__ void p0b_load(const Frame& F, int m0, f32x4 (&v)[P0B_RPI][4]) {
#pragma unroll
    for (int q = 0; q < P0B_RPI; ++q) { const int m = (m0 + q) < MT ? (m0 + q) : (MT - 1);
        const float* xrow = m < M ? F.x + (size_t)m * D : F.ctx + (size_t)(m - M) * D; const GAS f32x4* xr = (const GAS f32x4*)xrow + F.lane;
#pragma unroll
        for (int j = 0; j < 4; ++j) v[q][j] = __builtin_nontemporal_load(xr + 64 * j); }
}
__device__ __forceinline__ void p0b_rows(const Frame& F, bf16* xn, const float* MOD, int m0, const f32x4 (&v)[P0B_RPI][4], int& curb, f32x4 (&gs)[4], f32x4 (&sh)[4]) {
#pragma unroll
    for (int q = 0; q < P0B_RPI; ++q) { const int m = m0 + q; if (m < MT) {
        const int bidx = m < M ? m / L : 16;
        if (bidx != curb) {
#pragma unroll
            for (int j = 0; j < 4; ++j) { const int kk = 4 * F.lane + 256 * j; const f32x4 g = *(const f32x4*)(F.norm1_g + kk), sc = *(const f32x4*)(MOD + (size_t)bidx * 6144 + 1024 + kk);
                gs[j] = g * (1.f + sc); sh[j] = *(const f32x4*)(MOD + (size_t)bidx * 6144 + kk); }
            curb = bidx;
        }
        float s_ = 0.f;
#pragma unroll
        for (int j = 0; j < 4; ++j) s_ += (v[q][j].x * v[q][j].x + v[q][j].y * v[q][j].y) + (v[q][j].z * v[q][j].z + v[q][j].w * v[q][j].w);
        const float rstd = rsqrtf(wave_sum(s_) * (1.f / D) + EPS);
        GAS v2u* o8 = (GAS v2u*)(xn + (size_t)m * D) + F.lane;
#pragma unroll
        for (int j = 0; j < 4; ++j) { const f32x4 y = v[q][j] * rstd * gs[j] + sh[j]; v2u w; w.x = pg8::cvt_pk_bf16(y.x, y.y); w.y = pg8::cvt_pk_bf16(y.z, y.w); o8[64 * j] = w; } } }
}
__device__ __forceinline__ void p0b_phase(Frame& F, bf16* xn) {
    const int gw = F.vcu * NWAVES + F.wave, NGW = F.G * NWAVES; constexpr int RPI = P0B_RPI;
    const float* MOD = (const float*)(F.ws + WS_MOD);
    f32x4 va[RPI][4], vb[RPI][4];
    const int W = RPI * NGW;
    int m0 = RPI * gw, m1 = m0 + W;
    if (m0 < MT) p0b_load(F, m0, va);
    if (m1 < MT) p0b_load(F, m1, vb);
    mod_wait(F);
    STAMP(50);
    int curb = -1; f32x4 gs[4], sh[4];
    while (m0 < MT) {
        p0b_rows(F, xn, MOD, m0, va, curb, gs, sh);
        const int m2 = m1 + W; if (m2 < MT) p0b_load(F, m2, va);
        if (m1 >= MT) break;
        p0b_rows(F, xn, MOD, m1, vb, curb, gs, sh);
        const int m3 = m2 + W; if (m3 < MT) p0b_load(F, m3, vb);
        m0 = m2; m1 = m3;
    }
    STAMP(52);
}

using pg8::Unit;
template <int CTRL> __device__ __forceinline__ float dppf(float x) { return __builtin_bit_cast(float, __builtin_amdgcn_update_dpp(0, __builtin_bit_cast(int, x), CTRL, 0xF, 0xF, false)); }

struct EpiOut {
    static constexpr bool PERM = true, AFTER_DRAIN = false, APERM = false, FASTPRO = true; static constexpr int STAMP_PH = 5; static constexpr bool PRO_HOOK = false;
    const float* x; bf16* x1; bf16* a2; const float* mod; const float* n2g; float* ssq;
    __device__ __forceinline__ void operator()(const f32x4 (&acc)[2][2][4][2], const Unit& u, int wr, int wc, int fr, int fq) const {
        asm volatile("" : "+v"(fr), "+v"(fq));
        const int b = (u.pm * 256) / L, colb = u.pn * 256 + wc * 32 + 8 * fq;
        f32x4 g1v[2][2], gsv[2][2];
#pragma unroll
        for (int bj = 0; bj < 2; ++bj)
#pragma unroll
            for (int n = 0; n < 2; ++n) { const int c = colb + bj * 128 + 4 * n;
                g1v[bj][n] = *(const f32x4*)(mod + (size_t)b * 6144 + 2048 + c);
                gsv[bj][n] = *(const f32x4*)(n2g + c) * (1.f + *(const f32x4*)(mod + (size_t)b * 6144 + 4096 + c)); }
#pragma unroll
        for (int ai = 0; ai < 2; ++ai) {
            f32x4 xa[4][2], xb[4][2];
#pragma unroll
            for (int m = 0; m < 4; ++m)
#pragma unroll
                for (int bj = 0; bj < 2; ++bj) { const size_t off = ((size_t)u.pm * 256 + ai * 128 + wr * 64 + m * 16 + fr) * D + colb + bj * 128; xa[m][bj] = __builtin_nontemporal_load((const f32x4*)(x + off)); xb[m][bj] = __builtin_nontemporal_load((const f32x4*)(x + off + 4)); }
            __builtin_amdgcn_sched_barrier(0);
#pragma unroll
            for (int m = 0; m < 4; ++m) {
                const size_t row = (size_t)u.pm * 256 + ai * 128 + wr * 64 + m * 16 + fr; float q = 0.f;
#pragma unroll
                for (int bj = 0; bj < 2; ++bj) {
                    const size_t off = row * D + colb + bj * 128;
                    const f32x4 v0 = xa[m][bj] + g1v[bj][0] * acc[ai][bj][m][0], v1 = xb[m][bj] + g1v[bj][1] * acc[ai][bj][m][1];
                    { v4u w1; w1.x = pg8::cvt_pk_bf16(v0.x, v0.y); w1.y = pg8::cvt_pk_bf16(v0.z, v0.w); w1.z = pg8::cvt_pk_bf16(v1.x, v1.y); w1.w = pg8::cvt_pk_bf16(v1.z, v1.w); *(v4u*)(x1 + off) = w1; }
                    q += (v0.x * v0.x + v0.y * v0.y) + (v0.z * v0.z + v0.w * v0.w) + (v1.x * v1.x + v1.y * v1.y) + (v1.z * v1.z + v1.w * v1.w);
                    const f32x4 a0 = v0 * gsv[bj][0], a1 = v1 * gsv[bj][1];
                    v4u w; w.x = pg8::cvt_pk_bf16(a0.x, a0.y); w.y = pg8::cvt_pk_bf16(a0.z, a0.w); w.z = pg8::cvt_pk_bf16(a1.x, a1.y); w.w = pg8::cvt_pk_bf16(a1.z, a1.w);
                    *(v4u*)(a2 + off) = w;
                }
                q = xsum32(xsum16(q));
                if (fq == 0) ssq[(size_t)(u.pn * 4 + wc) * M + row] = q;
            }
        }
    }
};

__device__ __forceinline__ v4u pk8v(const f32x4 a, const f32x4 b) { v4u w; w.x = pg8::cvt_pk_bf16(a.x, a.y); w.y = pg8::cvt_pk_bf16(a.z, a.w); w.z = pg8::cvt_pk_bf16(b.x, b.y); w.w = pg8::cvt_pk_bf16(b.z, b.w); return w; }
__device__ __forceinline__ f32x4 unpk4(const v2u w) { return (f32x4){__builtin_bit_cast(float, w.x << 16), __builtin_bit_cast(float, w.x & 0xffff0000u), __builtin_bit_cast(float, w.y << 16), __builtin_bit_cast(float, w.y & 0xffff0000u)}; }
struct EpiUp {
    static constexpr bool PERM = true, AFTER_DRAIN = false, APERM = true, FASTPRO = true; static constexpr int STAMP_PH = 6; static constexpr bool PRO_HOOK = false;
    const float* ssq1; const float* bias2; const float* cw; const float* cb; bf16* hid; bf16* edge_g;
    __device__ __forceinline__ void operator()(const f32x4 (&acc)[2][2][4][2], const Unit& u, int wr, int wc, int fr, int fq) const {
        asm volatile("" : "+v"(fr), "+v"(fq));
        const int b = (u.pm * 256) / L, j = u.pn, cc0 = wc * 32 + 8 * fq;
        f32x4 sp[2][4], bg[2], bu[2], cw0[2], cw1[2], cw2[2], cbv[2];
#pragma unroll
        for (int ai = 0; ai < 2; ++ai)
#pragma unroll
            for (int m = 0; m < 4; ++m) sp[ai][m] = *(const f32x4*)(ssq1 + (size_t)(4 * fq + m) * M + (u.pm * 256 + ai * 128 + wr * 64 + 4 * fr));
#pragma unroll
        for (int n = 0; n < 2; ++n) { const int c = 128 * j + cc0 + 4 * n;
            bg[n] = *(const f32x4*)(bias2 + (size_t)b * DUP + 256 * j + cc0 + 4 * n); bu[n] = *(const f32x4*)(bias2 + (size_t)b * DUP + 256 * j + 128 + cc0 + 4 * n);
            cw0[n] = *(const f32x4*)(cw + c); cw1[n] = *(const f32x4*)(cw + DFF + c); cw2[n] = *(const f32x4*)(cw + 2 * DFF + c); cbv[n] = *(const f32x4*)(cb + c); }
        __builtin_amdgcn_sched_barrier(0);
        float rs[2][4];
#pragma unroll
        for (int ai = 0; ai < 2; ++ai)
#pragma unroll
            for (int m = 0; m < 4; ++m) { float s_ = (sp[ai][0][m] + sp[ai][1][m]) + (sp[ai][2][m] + sp[ai][3][m]); s_ = xsum32(xsum16(s_)); rs[ai][m] = rsqrtf(s_ * (1.f / D) + EPS); }
#pragma unroll
        for (int ai = 0; ai < 2; ++ai) {
            const int row0 = u.pm * 256 + ai * 128 + wr * 64, blk = row0 >> 6;
            f32x4 Gv[2][4], pv[2], nx[2];
#pragma unroll
            for (int n = 0; n < 2; ++n) {
#pragma unroll
                for (int m = 0; m < 4; ++m) Gv[n][m] = acc[ai][0][m][n] * rs[ai][m] + bg[n];
#pragma unroll
                for (int i = 0; i < 4; ++i) { pv[n][i] = dppf<0x111>(Gv[n][3][i]); nx[n][i] = dppf<0x101>(Gv[n][0][i]); }
            }
#pragma unroll
            for (int m = 0; m < 4; ++m) {
                v4u w;
#pragma unroll
                for (int n = 0; n < 2; ++n) {
                    const int c = 128 * j + cc0 + 4 * n;
                    const f32x4 Uv = acc[ai][1][m][n] * rs[ai][m] + bu[n];
                    const f32x4 prev = m > 0 ? Gv[n][m > 0 ? m - 1 : 0] : pv[n], next = m < 3 ? Gv[n][m < 3 ? m + 1 : 3] : nx[n];
                    const f32x4 gt = cw0[n] * prev + cw1[n] * Gv[n][m] + cw2[n] * next + cbv[n];
                    const f32x4 tn = gt * -1.4426950408889634f; f32x4 ex; ex.x = __builtin_amdgcn_exp2f(tn.x); ex.y = __builtin_amdgcn_exp2f(tn.y); ex.z = __builtin_amdgcn_exp2f(tn.z); ex.w = __builtin_amdgcn_exp2f(tn.w);
                    const f32x4 dn = ex + 1.f; f32x4 rc; rc.x = __builtin_amdgcn_rcpf(dn.x); rc.y = __builtin_amdgcn_rcpf(dn.y); rc.z = __builtin_amdgcn_rcpf(dn.z); rc.w = __builtin_amdgcn_rcpf(dn.w);
                    f32x4 h = (gt * Uv) * rc;
                    if ((m == 0 && fr == 0) || (m == 3 && fr == 15)) h = Uv;
                    if (n == 0) { w.x = pg8::cvt_pk_bf16(h.x, h.y); w.y = pg8::cvt_pk_bf16(h.z, h.w); } else { w.z = pg8::cvt_pk_bf16(h.x, h.y); w.w = pg8::cvt_pk_bf16(h.z, h.w); }
                }
                *(v4u*)(hid + (size_t)(row0 + 4 * fr + m) * DFF + 128 * j + cc0) = w;
            }
            {   const size_t eo = (size_t)128 * j + cc0;
                if (fr == 0) { *(v4u*)(edge_g + ((size_t)blk * 4 + 0) * DFF + eo) = pk8v(Gv[0][0], Gv[1][0]); *(v4u*)(edge_g + ((size_t)blk * 4 + 1) * DFF + eo) = pk8v(Gv[0][1], Gv[1][1]); }
                if (fr == 15) { *(v4u*)(edge_g + ((size_t)blk * 4 + 2) * DFF + eo) = pk8v(Gv[0][2], Gv[1][2]); *(v4u*)(edge_g + ((size_t)blk * 4 + 3) * DFF + eo) = pk8v(Gv[0][3], Gv[1][3]); } }
        }
    }
};

struct EpiDownNorm {
    static constexpr bool PERM = true, AFTER_DRAIN = false, APERM = false, FASTPRO = true; static constexpr int STAMP_PH = 8; static constexpr bool PRO_HOOK = false;
    const bf16* x1; float* out; const float* mod; const float* fg; float* xbuf; unsigned* cnt; LAS unsigned char* sp;
    __device__ __forceinline__ void operator()(const f32x4 (&acc_)[2][2][4][2], const Unit& u, int wr, int wc, int fr, int fq) const {
        asm volatile("" : "+v"(fr), "+v"(fq));
        f32x4 (&acc)[2][2][4][2] = const_cast<f32x4 (&)[2][2][4][2]>(acc_);
        const int b = (u.pm * 256) / L, colb = u.pn * 256 + wc * 32 + 8 * fq, wid = wr * 4 + wc, lane = fq * 16 + fr;
        LAS float* P = (LAS float*)sp; LAS float* S = (LAS float*)(sp + 4096); LAS unsigned* flag = (LAS unsigned*)(sp + 5120);
        f32x4 g2v[2][2];
#pragma unroll
        for (int bj = 0; bj < 2; ++bj)
#pragma unroll
            for (int n = 0; n < 2; ++n) g2v[bj][n] = *(const f32x4*)(mod + (size_t)b * 6144 + 5120 + colb + bj * 128 + 4 * n);
#pragma unroll
        for (int ai = 0; ai < 2; ++ai) {
            v4u xw[4][2];
#pragma unroll
            for (int m = 0; m < 4; ++m)
#pragma unroll
                for (int bj = 0; bj < 2; ++bj) xw[m][bj] = __builtin_nontemporal_load((const v4u*)(x1 + ((size_t)u.pm * 256 + ai * 128 + wr * 64 + m * 16 + fr) * D + colb + bj * 128));
            __builtin_amdgcn_sched_barrier(0);
#pragma unroll
            for (int m = 0; m < 4; ++m) { float q = 0.f;
#pragma unroll
                for (int bj = 0; bj < 2; ++bj) { const v4u w = xw[m][bj];
                    const f32x4 xa = {bf2f(w.x & 0xffff), bf2f(w.x >> 16), bf2f(w.y & 0xffff), bf2f(w.y >> 16)}, xb = {bf2f(w.z & 0xffff), bf2f(w.z >> 16), bf2f(w.w & 0xffff), bf2f(w.w >> 16)};
                    const f32x4 y0 = xa + g2v[bj][0] * acc[ai][bj][m][0], y1 = xb + g2v[bj][1] * acc[ai][bj][m][1]; acc[ai][bj][m][0] = y0; acc[ai][bj][m][1] = y1;
                    q += (y0.x * y0.x + y0.y * y0.y) + (y0.z * y0.z + y0.w * y0.w) + (y1.x * y1.x + y1.y * y1.y) + (y1.z * y1.z + y1.w * y1.w); }
                q = xsum32(xsum16(q));
                if (fq == 0) P[(ai * 128 + wr * 64 + m * 16 + fr) * 4 + wc] = q; }
        }
        asm volatile("s_waitcnt lgkmcnt(0)" ::: "memory"); __builtin_amdgcn_s_barrier(); asm volatile("" ::: "memory");
        const int row = wid * 32 + (lane & 31);
        if (lane < 32) { const float t = (P[row * 4 + 0] + P[row * 4 + 1]) + (P[row * 4 + 2] + P[row * 4 + 3]);
            __hip_atomic_store(xbuf + ((size_t)u.pm * 4 + u.pn) * 256 + row, t, __ATOMIC_RELAXED, __HIP_MEMORY_SCOPE_AGENT); }
        asm volatile("s_waitcnt vmcnt(0)" ::: "memory");
        if (lane == 0) __hip_atomic_fetch_add(cnt + 64 * u.pm, 1u, __ATOMIC_RELAXED, __HIP_MEMORY_SCOPE_AGENT);
        if (wid == 0) {
            unsigned spn = 0;
            while ((unsigned)__builtin_amdgcn_readfirstlane(__hip_atomic_load(cnt + 64 * u.pm, __ATOMIC_RELAXED, __HIP_MEMORY_SCOPE_AGENT)) < 32u) { __builtin_amdgcn_s_sleep(2); if (++spn > (1u << 22)) break; }
            __builtin_amdgcn_fence(__ATOMIC_ACQUIRE, "agent");
            if (lane == 0) flag[0] = spn;
        }
        asm volatile("s_waitcnt vmcnt(0) lgkmcnt(0)" ::: "memory"); __builtin_amdgcn_s_barrier(); asm volatile("" ::: "memory");
        if (lane < 32) { const float* slot = xbuf + (size_t)u.pm * 1024 + row; float t = 0.f;
#pragma unroll
            for (int k = 0; k < 4; ++k) t += __hip_atomic_load(slot + 256 * k, __ATOMIC_RELAXED, __HIP_MEMORY_SCOPE_AGENT);
            S[row] = rsqrtf(t * (1.f / D) + EPS); }
        asm volatile("s_waitcnt lgkmcnt(0)" ::: "memory"); __builtin_amdgcn_s_barrier(); asm volatile("" ::: "memory");
        f32x4 fgv[2][2];
#pragma unroll
        for (int bj = 0; bj < 2; ++bj)
#pragma unroll
            for (int n = 0; n < 2; ++n) fgv[bj][n] = *(const f32x4*)(fg + colb + bj * 128 + 4 * n);
#pragma unroll
        for (int ai = 0; ai < 2; ++ai)
#pragma unroll
            for (int m = 0; m < 4; ++m) { const int r = ai * 128 + wr * 64 + m * 16 + fr; const float rs = S[r];
#pragma unroll
                for (int bj = 0; bj < 2; ++bj) { const size_t off = ((size_t)u.pm * 256 + r) * D + colb + bj * 128;
                    *(f32x4*)(out + off) = acc[ai][bj][m][0] * rs * fgv[bj][0]; *(f32x4*)(out + off + 4) = acc[ai][bj][m][1] * rs * fgv[bj][1]; } }
        asm volatile("s_waitcnt lgkmcnt(0)" ::: "memory"); __builtin_amdgcn_s_barrier(); asm volatile("" ::: "memory");
    }
};

struct EpiIn {
    static constexpr bool PERM = true, AFTER_DRAIN = false, APERM = true, FASTPRO = true; static constexpr int STAMP_PH = 2; static constexpr bool PRO_HOOK = true;
    unsigned char* ws; LAS const unsigned char* tab; const float* hgrn_lb; const float* ret_decay;
    static constexpr int TAB_LB = 64 * 272, TAB_LG = TAB_LB + 4096;
    static __device__ __forceinline__ v2u pk4(const f32x4 a) { v2u w; w.x = pg8::cvt_pk_bf16(a.x, a.y); w.y = pg8::cvt_pk_bf16(a.z, a.w); return w; }
    static __device__ __forceinline__ v4u pk8(const f32x4 a, const f32x4 b) { v4u w; w.x = pg8::cvt_pk_bf16(a.x, a.y); w.y = pg8::cvt_pk_bf16(a.z, a.w); w.z = pg8::cvt_pk_bf16(b.x, b.y); w.w = pg8::cvt_pk_bf16(b.z, b.w); return w; }
    static __device__ __forceinline__ v4u pair16(const v2u a, const v2u b) { const v2u r0 = __builtin_amdgcn_permlane16_swap(a.x, b.x, false, false), r1 = __builtin_amdgcn_permlane16_swap(a.y, b.y, false, false); return (v4u){r0.x, r1.x, r0.y, r1.y}; }
    static __device__ __forceinline__ f32x4 sig4(const f32x4 x) { const f32x4 t = x * -1.4426950408889634f; f32x4 e; e.x = __builtin_amdgcn_exp2f(t.x); e.y = __builtin_amdgcn_exp2f(t.y); e.z = __builtin_amdgcn_exp2f(t.z); e.w = __builtin_amdgcn_exp2f(t.w);
        const f32x4 d = e + 1.f; f32x4 r; r.x = __builtin_amdgcn_rcpf(d.x); r.y = __builtin_amdgcn_rcpf(d.y); r.z = __builtin_amdgcn_rcpf(d.z); r.w = __builtin_amdgcn_rcpf(d.w); return r; }
    static __device__ __forceinline__ void sig4c(const f32x4 x, f32x4& sg, f32x4& nsg) { const f32x4 t = x * -1.4426950408889634f; f32x4 e; e.x = __builtin_amdgcn_exp2f(t.x); e.y = __builtin_amdgcn_exp2f(t.y); e.z = __builtin_amdgcn_exp2f(t.z); e.w = __builtin_amdgcn_exp2f(t.w);
        const f32x4 d = e + 1.f; f32x4 r; r.x = __builtin_amdgcn_rcpf(d.x); r.y = __builtin_amdgcn_rcpf(d.y); r.z = __builtin_amdgcn_rcpf(d.z); r.w = __builtin_amdgcn_rcpf(d.w); sg = r; nsg = e * r; }
    static __device__ __forceinline__ f32x4 rcp4(const f32x4 d) { f32x4 r; r.x = __builtin_amdgcn_rcpf(d.x); r.y = __builtin_amdgcn_rcpf(d.y); r.z = __builtin_amdgcn_rcpf(d.z); r.w = __builtin_amdgcn_rcpf(d.w); return r; }
#define MULDPP(S, CTRLSTR) asm volatile("s_nop 1\n\tv_mul_f32_dpp %0, %0, %0 " CTRLSTR " row_mask:0xf bank_mask:0xf\n\ts_nop 1" : "+v"(S))
    template <int CTRL> static __device__ __forceinline__ float dpp1(float x) { return __builtin_bit_cast(float, __builtin_amdgcn_update_dpp(0x3f800000, __builtin_bit_cast(int, x), CTRL, 0xF, 0xF, false)); }
    static __device__ __forceinline__ void pscan64(f32x4 (&x)[4], f32x4& tot, int fr) {
#pragma unroll
        for (int i = 0; i < 4; ++i) {
            const float p0 = x[0][i], p1 = p0 * x[1][i], p2 = p1 * x[2][i], p3 = p2 * x[3][i];
            float s = p3, a;
            MULDPP(s, "row_shr:1"); MULDPP(s, "row_shr:2"); MULDPP(s, "row_shr:4"); MULDPP(s, "row_shr:8"); (void)a;
            const float e = dpp1<0x111>(s);
            tot[i] = dppf<0x15F>(s);
            x[0][i] = p0 * e; x[1][i] = p1 * e; x[2][i] = p2 * e; x[3][i] = p3 * e;
        }
    }
    static __device__ __forceinline__ void sscan64(f32x4 (&x)[4], f32x4& tot, int fr) {
#pragma unroll
        for (int i = 0; i < 4; ++i) {
            const float s3 = x[3][i], s2 = s3 * x[2][i], s1 = s2 * x[1][i], s0 = s1 * x[0][i];
            float s = s0, a;
            MULDPP(s, "row_shl:1"); MULDPP(s, "row_shl:2"); MULDPP(s, "row_shl:4"); MULDPP(s, "row_shl:8"); (void)a;
            const float e = dpp1<0x101>(s);
            tot[i] = dppf<0x150>(s);
            x[0][i] = s0 * e; x[1][i] = s1 * e; x[2][i] = s2 * e; x[3][i] = s3 * e;
        }
    }
    __device__ __forceinline__ void pro_hook(int tid) const {
        LAS unsigned char* t_ = const_cast<LAS unsigned char*>(tab);
        const unsigned char* rope = ws + WS_ROPE;
        for (int ch = tid; ch < 1024; ch += NWAVES * 64) { const int pos = ch >> 4; *(LAS f32x4*)(t_ + ((pos & 3) * 16 + (pos >> 2)) * 272 + (ch & 15) * 16) = *(const f32x4*)(rope + ch * 16); }
        { const int t = tid; const float a0f = hgrn_lb[t], a1f = hgrn_lb[512 + t], a0b = hgrn_lb[1024 + t], a1b = hgrn_lb[1536 + t];
          *(LAS float*)(t_ + TAB_LB + t * 4) = __builtin_amdgcn_rcpf(1.f + __expf(a1f - a0f)); *(LAS float*)(t_ + TAB_LB + 2048 + t * 4) = __builtin_amdgcn_rcpf(1.f + __expf(a1b - a0b));
          if (t < 8) *(LAS float*)(t_ + TAB_LG + t * 4) = -log1pf(expf(-ret_decay[t])); }
        __syncthreads();
    }
    __device__ __forceinline__ void operator()(const f32x4 (&acc)[2][2][4][2], const Unit& u, int wr, int wc, int fr, int fq) const {
        asm volatile("" : "+v"(fr), "+v"(fq));
        const int tile = u.pn; const bool isctx = u.pm >= 128;
        const int cc0 = wc * 32 + 8 * fq;
        bf16* const qf = (bf16*)(ws + WS_QF); bf16* const kf = (bf16*)(ws + WS_KF); bf16* const qb = (bf16*)(ws + WS_QB); bf16* const kb = (bf16*)(ws + WS_KB); bf16* const v = (bf16*)(ws + WS_V); bf16* const g = (bf16*)(ws + WS_G);
        float* const df = (float*)(ws + WS_DF); float* const db = (float*)(ws + WS_DB);
        if (tile < 8) {
            const int h = tile >> 1, kh = tile & 1, key0 = 64 * kh + 16 * wc + 4 * fq, hc = h * 128 + key0;
            const f32x4 lbf = *(LAS const f32x4*)(tab + TAB_LB + hc * 4), lbb = *(LAS const f32x4*)(tab + TAB_LB + 2048 + hc * 4);
            const f32x4 omf = 1.f - lbf, omb = 1.f - lbb;
#pragma unroll
            for (int ai = 0; ai < 2; ++ai) {
                const size_t row0 = (size_t)u.pm * 256 + ai * 128 + wr * 64;
                const int odd = fq & 1; const size_t o0 = (row0 + 4 * fr) * D + hc - 4 * odd;
                {
                    f32x4 pf[4], kk[4], tot;
#pragma unroll
                    for (int m = 0; m < 4; ++m) { f32x4 sg, nsg; sig4c(acc[ai][0][m][1], sg, nsg); pf[m] = omf * sg + lbf; kk[m] = omf * nsg; }
                    pscan64(pf, tot, fr);
                    v2u pq[4], pk[4], pv[4];
#pragma unroll
                    for (int m = 0; m < 4; ++m) { const f32x4 qv = acc[ai][0][m][0] * pf[m], kv = kk[m] * rcp4(pf[m]);
                        pq[m] = pk4(qv); pk[m] = pk4(kv); pv[m] = pk4(acc[ai][1][m][1]); }
                    if (!isctx) {
#pragma unroll
                        for (int m = 0; m < 4; ++m) *(v4u*)((odd ? kf : qf) + o0 + (size_t)m * D) = pair16(pq[m], pk[m]);
                    } else {
#pragma unroll
                        for (int m = 0; m < 4; m += 2) *(v4u*)(kf + o0 + (size_t)(m + odd) * D) = pair16(pk[m], pk[m + 1]);
                    }
#pragma unroll
                    for (int m = 0; m < 4; m += 2) *(v4u*)(v + o0 + (size_t)(m + odd) * D) = pair16(pv[m], pv[m + 1]);
                    if (fr == 0) *(f32x4*)(df + (row0 >> 6) * 512 + hc) = tot;
                }
                asm volatile("" ::: "memory");
                {
                    f32x4 pf[4], kk[4], tot;
#pragma unroll
                    for (int m = 0; m < 4; ++m) { f32x4 sg, nsg; sig4c(acc[ai][1][m][0], sg, nsg); pf[m] = omb * sg + lbb; kk[m] = omb * nsg; }
                    sscan64(pf, tot, fr);
                    v2u pq[4], pk[4];
#pragma unroll
                    for (int m = 0; m < 4; ++m) { const f32x4 qv = acc[ai][0][m][0] * pf[m], kv = kk[m] * rcp4(pf[m]);
                        pq[m] = pk4(qv); pk[m] = pk4(kv); }
                    if (!isctx) {
#pragma unroll
                        for (int m = 0; m < 4; ++m) *(v4u*)((odd ? kb : qb) + o0 + (size_t)m * D) = pair16(pq[m], pk[m]);
                    } else {
#pragma unroll
                        for (int m = 0; m < 4; m += 2) *(v4u*)(kb + o0 + (size_t)(m + odd) * D) = pair16(pk[m], pk[m + 1]);
                    }
                    if (fr == 0) *(f32x4*)(db + (row0 >> 6) * 512 + hc) = tot;
                }
                asm volatile("" ::: "memory");
            }
        } else if (tile < 10 || tile >= 14) {
            const int kind = tile < 10 ? 0 : (tile < 16 ? 1 : 2);
            const int cbase = (kind == 0 ? 256 * (tile - 8) : (kind == 1 ? 512 + 256 * (tile - 14) : 512 + 256 * (tile - 16))) + cc0;
            bf16* dst = kind == 1 ? v : g;
#pragma unroll
            for (int ai = 0; ai < 2; ++ai)
#pragma unroll
                for (int m = 0; m < 4; ++m) { const size_t row = (size_t)u.pm * 256 + ai * 128 + wr * 64 + 4 * fr + m;
#pragma unroll
                    for (int bj = 0; bj < 2; ++bj) { f32x4 a = acc[ai][bj][m][0], b = acc[ai][bj][m][1];
                        if (kind == 0) { a = sig4(a); b = sig4(b); }
                        if (kind == 2) { a = a * sig4(a); b = b * sig4(b); }
                        *(v4u*)(dst + row * D + cbase + 128 * bj) = pk8(a, b); } }
        } else {
            const bool isq = tile < 12; const int hbase = 2 * (tile - (isq ? 10 : 12));
            const int half = wc >> 1, i0b = ((cc0 & 63) >> 1);
            float lg[2][2];
#pragma unroll
            for (int bj = 0; bj < 2; ++bj)
#pragma unroll
                for (int d = 0; d < 2; ++d) lg[bj][d] = *(LAS const float*)(tab + TAB_LG + (d * 4 + hbase + bj) * 4);
            const float sgn = isq ? 1.f : -1.f, scl = isq ? 1.f : 0.08838834764831845f;
#pragma unroll
            for (int ai = 0; ai < 2; ++ai) {
                f32x4 cs01[4], cs23[4];
#pragma unroll
                for (int m = 0; m < 4; ++m) { cs01[m] = (f32x4){1.f, 0.f, 1.f, 0.f}; cs23[m] = (f32x4){1.f, 0.f, 1.f, 0.f};
                    if (!isctx) { const size_t row = (size_t)u.pm * 256 + ai * 128 + wr * 64 + 4 * fr + m; const int pos = half == 0 ? (int)((row & 2047) >> 6) : (4 * fr + m); LAS const unsigned char* rp = tab + ((pos & 3) * 16 + (pos >> 2)) * 272 + i0b * 8;
                        cs01[m] = *(LAS const f32x4*)rp; cs23[m] = *(LAS const f32x4*)(rp + 16); } }
#pragma unroll
                for (int m = 0; m < 4; ++m) {
                    const size_t row = (size_t)u.pm * 256 + ai * 128 + wr * 64 + 4 * fr + m; const int ic = 4 * fr + m;
                    const f32x4 c01 = cs01[m], c23 = cs23[m];
#pragma unroll
                    for (int bj = 0; bj < 2; ++bj) {
                        const f32x4 a = acc[ai][bj][m][0] * scl, b = acc[ai][bj][m][1] * scl; f32x4 ra, rb;
                        ra.x = a.x * c01.x - a.y * c01.y; ra.y = a.x * c01.y + a.y * c01.x; ra.z = a.z * c01.z - a.w * c01.w; ra.w = a.z * c01.w + a.w * c01.z;
                        rb.x = b.x * c23.x - b.y * c23.y; rb.y = b.x * c23.y + b.y * c23.x; rb.z = b.z * c23.z - b.w * c23.w; rb.w = b.z * c23.w + b.w * c23.z;
                        const size_t o = row * D + 512 + (hbase + bj) * 128 + cc0;
                        if (isq) { *(v4u*)(qf + o) = pk8(ra, rb); }
                        else { *(v4u*)(kf + o) = pk8(ra, rb); }
                    }
                }
            }
        }
    }
};
struct InOrder {
    pg8::StaticOrder so; int G, c;
    __device__ void init(int G_, int c_) { so.init(M, NIN, G_, c_); G = G_; c = c_; }
    __device__ bool next(int i, Unit& u) const {
        const long Li = (long)i * G + c;
        if (Li < 2304) return so.next(i, u);
        const int r = (int)(Li - 2304); if (r >= 192) return false;
        u.pm = 128 + r / 12; const int q = r % 12; u.pn = q < 8 ? q : q + 4; return true;
    }
    __device__ __forceinline__ void a_ready(const Unit&) const {}
    __device__ __forceinline__ void done(const Unit&) const {}
};


__device__ __forceinline__ f32x4 unpk4(const v2u w);
struct EdgeItem { v4u pw, cw, nw, uw; int row, c; bool act; };
__device__ __forceinline__ void edge_load(const Frame& F, int it, EdgeItem& e) {
    const bf16* EG = (const bf16*)(F.ws + WS_EDGEG); const bf16* hid = (const bf16*)(F.ws + WS_HID);
    const int er = it / 6, q = it % 6, blk = er >> 1, e2 = er & 1, c0 = 512 * q + 8 * F.lane;
    e.act = c0 < DFF; e.c = e.act ? c0 : 0; e.row = 64 * blk + (e2 ? 63 : 0); const int t = e.row % L, c = e.c;
    const v4u z = {0u, 0u, 0u, 0u}; e.pw = z; e.nw = z;
    if (e2 == 0) { if (t != 0) e.pw = __builtin_nontemporal_load((const v4u*)(EG + ((size_t)(blk - 1) * 4 + 3) * DFF + c)); e.cw = __builtin_nontemporal_load((const v4u*)(EG + ((size_t)blk * 4 + 0) * DFF + c)); e.nw = __builtin_nontemporal_load((const v4u*)(EG + ((size_t)blk * 4 + 1) * DFF + c)); }
    else { e.pw = __builtin_nontemporal_load((const v4u*)(EG + ((size_t)blk * 4 + 2) * DFF + c)); e.cw = __builtin_nontemporal_load((const v4u*)(EG + ((size_t)blk * 4 + 3) * DFF + c)); if (t != L - 1) e.nw = __builtin_nontemporal_load((const v4u*)(EG + ((size_t)(blk + 1) * 4 + 0) * DFF + c)); }
    e.uw = *(const v4u*)(hid + (size_t)e.row * DFF + c);
}
__device__ __forceinline__ void edge_finish(const Frame& F, const EdgeItem& e) {
    bf16* hid = (bf16*)(F.ws + WS_HID); const int c = e.c; v4u w;
#pragma unroll
    for (int hf = 0; hf < 2; ++hf) {
        const v2u pw = hf ? (v2u){e.pw.z, e.pw.w} : (v2u){e.pw.x, e.pw.y}, cw = hf ? (v2u){e.cw.z, e.cw.w} : (v2u){e.cw.x, e.cw.y}, nw = hf ? (v2u){e.nw.z, e.nw.w} : (v2u){e.nw.x, e.nw.y}, uw = hf ? (v2u){e.uw.z, e.uw.w} : (v2u){e.uw.x, e.uw.y};
        const f32x4 prev = unpk4(pw), cur = unpk4(cw), next = unpk4(nw), up = unpk4(uw); const int cc = c + 4 * hf;
        const f32x4 cw0 = *(const f32x4*)(F.conv_w + cc), cw1 = *(const f32x4*)(F.conv_w + DFF + cc), cw2 = *(const f32x4*)(F.conv_w + 2 * DFF + cc), cbv = *(const f32x4*)(F.conv_b + cc);
        const f32x4 gt = cw0 * prev + cw1 * cur + cw2 * next + cbv;
        const unsigned lo = pk2(siluf(gt.x) * up.x, siluf(gt.y) * up.y), hi = pk2(siluf(gt.z) * up.z, siluf(gt.w) * up.w);
        if (hf == 0) { w.x = lo; w.y = hi; } else { w.z = lo; w.w = hi; }
    }
    if (e.act) *(v4u*)(hid + (size_t)e.row * DFF + c) = w;
}
__device__ __forceinline__ void edge_phase(Frame& F) {
    const int gw = F.vcu * NWAVES + F.wave, NGW = F.G * NWAVES; constexpr int NIT = 1024 * 6;
    for (int it = gw; it < NIT; it += 2 * NGW) {
        EdgeItem a, b; const bool hb = it + NGW < NIT;
        edge_load(F, it, a); if (hb) edge_load(F, it + NGW, b);
        edge_finish(F, a); if (hb) edge_finish(F, b);
    }
}

namespace mx {
typedef float f32x16 __attribute__((ext_vector_type(16)));
typedef float f32x8 __attribute__((ext_vector_type(8)));
typedef __bf16 bf8 __attribute__((ext_vector_type(8)));
typedef short s16x4 __attribute__((ext_vector_type(4)));
typedef short s16x8 __attribute__((ext_vector_type(8)));
#define MX_MFMA(a, b, c) __builtin_amdgcn_mfma_f32_32x32x16_bf16((a), (b), (c), 0, 0, 0)
constexpr int MX_NT = 2;
constexpr int IMG = 16384, BUFB = 3 * IMG, NBUF = 2, EXI_OFF = NBUF * BUFB, GTI_OFF = EXI_OFF + IMG, SSQ_OFF = GTI_OFF + IMG, DVEC_OFF = SSQ_OFF + 1024, GN_OFF = DVEC_OFF + 2048, CTXDV_OFF = GN_OFF + 512, PT_OFF = CTXDV_OFF + 4096;
__device__ __forceinline__ unsigned off_b(unsigned row, unsigned ch) { return 256u * row + 16u * (ch ^ (((row & 3u) << 2) | ((row >> 2) & 3u))); }
__device__ __forceinline__ int crow(int reg, int h) { return (reg & 3) + 8 * (reg >> 2) + 4 * h; }
__device__ __forceinline__ s16x8 pack_step(const f32x16& x, int s) { f32x8 t;
#pragma unroll
    for (int i = 0; i < 8; ++i) t[i] = x[8 * s + i];
    return __builtin_bit_cast(s16x8, __builtin_convertvector(t, bf8)); }
typedef float f32x2v __attribute__((ext_vector_type(2)));
typedef __bf16 bf2v __attribute__((ext_vector_type(2)));
__device__ __forceinline__ unsigned cvt2(float lo, float hi) { f32x2v t = {lo, hi}; return __builtin_bit_cast(unsigned, __builtin_convertvector(t, bf2v)); }
__device__ __forceinline__ s16x8 row_read(LAS unsigned char* img, unsigned row, unsigned ch) { return *(LAS s16x8*)(img + off_b(row, ch)); }
__device__ __forceinline__ s16x4 tr4(LAS unsigned char* p) { return __builtin_amdgcn_ds_read_tr16_b64_v4i16((LAS s16x4*)p); }
__device__ __forceinline__ s16x8 cat8(s16x4 lo, s16x4 hi) { return __builtin_shufflevector(lo, hi, 0, 1, 2, 3, 4, 5, 6, 7); }

__device__ __forceinline__ void stage_chunk(LAS unsigned char* buf, const bf16* q, const bf16* k, const bf16* v, size_t row0, int col0, int narr, int iw, int lane) {
    const int per = narr * 4;
    asm volatile("" : "+v"(lane));
    for (int qi = 0; qi < per; ++qi) {
        const int idx = iw * per + qi, a = idx >> 4, i = idx & 15, arr = a + (3 - narr);
        const bf16* base = arr == 0 ? q : (arr == 1 ? k : v);
        const unsigned rl = 4 * i + (lane >> 4), pos = lane & 15, ch = pos ^ (((rl & 3u) << 2) | ((rl >> 2) & 3u));
        const bf16* src = base + (row0 + rl) * (size_t)D + col0 + 8 * ch;
        __builtin_amdgcn_global_load_lds((const unsigned*)src, (LAS unsigned*)(buf + a * IMG + i * 1024), 16, 0, MX_NT);
    }
}

#define MX_SB() __builtin_amdgcn_sched_barrier(0)
template <bool FWD> __device__ __forceinline__ int tile_st(int tile) { return FWD ? (tile == 2 ? 1 : 0) : (tile == 0 ? 0 : 1); }
template <bool FWD> __device__ __forceinline__ int tile_tt(int tile) { return FWD ? (tile == 0 ? 0 : 1) : (tile == 2 ? 1 : 0); }
template <bool FWD>
__device__ __forceinline__ void ptile(LAS unsigned char* buf, LAS unsigned char* pt, int tile, int lane, bool isret, float lg) {
    LAS unsigned char* qimg = buf; LAS unsigned char* kimg = buf + IMG;
    const unsigned r = lane & 31, h = lane >> 5; const int st = tile_st<FWD>(tile), tt = tile_tt<FWD>(tile);
    f32x16 X;
#pragma unroll
    for (int i = 0; i < 16; ++i) X[i] = 0.f;
    s16x8 fa[8][2];
#pragma unroll
    for (int ks = 0; ks < 8; ++ks) { fa[ks][0] = row_read(kimg, 32 * st + r, 2 * ks + h); fa[ks][1] = row_read(qimg, 32 * tt + r, 2 * ks + h); }
#pragma unroll
    for (int ks = 0; ks < 8; ++ks) X = MX_MFMA(fa[ks][0], fa[ks][1], X);
    if (st == tt) {
#pragma unroll
        for (int i = 0; i < 16; ++i) { const int sl = crow(i, h); const bool keep = FWD ? ((int)r >= sl) : ((int)r <= sl); X[i] = keep ? X[i] : 0.f; }
    }
    if (isret) {
        const int t = 32 * tt + (int)r;
#pragma unroll
        for (int i = 0; i < 16; ++i) { const int sr = 32 * st + crow(i, h), dd = FWD ? t - sr : sr - t; X[i] *= __expf(lg * (float)(dd > 0 ? dd : 0)); }
    }
    *(LAS s16x8*)(pt + tile * 2048 + lane * 16) = pack_step(X, 0); *(LAS s16x8*)(pt + tile * 2048 + 1024 + lane * 16) = pack_step(X, 1);
}
__device__ __forceinline__ void state_frags(s16x4 (&f)[5][2], LAS unsigned char* kimg, LAS unsigned char* vimg, int KS, int w, int lane) {
    const unsigned h = lane >> 5, blk = (lane >> 4) & 1, q4 = (lane & 15) >> 2, p = lane & 3;
    const unsigned R0 = 16 * KS + 8 * h + q4, chv = 4 * w + 2 * blk + (p >> 1);
    f[0][0] = tr4(vimg + off_b(R0, chv) + 8 * (p & 1)); f[0][1] = tr4(vimg + off_b(R0 + 4, chv) + 8 * (p & 1));
#pragma unroll
    for (int kb = 0; kb < 4; ++kb) { const unsigned chk = 4 * kb + 2 * blk + (p >> 1);
        f[1 + kb][0] = tr4(kimg + off_b(R0, chk) + 8 * (p & 1)); f[1 + kb][1] = tr4(kimg + off_b(R0 + 4, chk) + 8 * (p & 1)); }
}
__device__ __forceinline__ void chunk_out_inter(LAS unsigned char* buf, const f32x16 (&S)[4], f32x16 (&o)[2], int lane, s16x4 (&fs0)[5][2], int w) {
    LAS unsigned char* qimg = buf;
    const unsigned r = lane & 31, h = lane >> 5;
#pragma unroll
    for (int i = 0; i < 16; ++i) { o[0][i] = 0.f; o[1][i] = 0.f; }
    s16x4 qf[2][4][4];
#pragma unroll
    for (int bt = 0; bt < 2; ++bt)
#pragma unroll
        for (int gi = 0; gi < 4; ++gi) { const int g = 4 * bt + gi, kb = g >> 1, st = g & 1;
#pragma unroll
            for (int tt = 0; tt < 2; ++tt)
#pragma unroll
                for (int e = 0; e < 2; ++e) qf[bt][gi][2 * tt + e] = *(LAS s16x4*)(qimg + off_b(32 * tt + r, 4 * kb + 2 * st + e) + 8 * h); }
    MX_SB();
#pragma unroll
    for (int gi = 0; gi < 4; ++gi) { const int kb = gi >> 1, st = gi & 1; const s16x8 xs = pack_step(S[kb], st);
        o[0] = MX_MFMA(xs, cat8(qf[0][gi][0], qf[0][gi][1]), o[0]); o[1] = MX_MFMA(xs, cat8(qf[0][gi][2], qf[0][gi][3]), o[1]); }
    MX_SB();
    state_frags(fs0, buf + IMG, buf + 2 * IMG, 0, w, lane); MX_SB();
#pragma unroll
    for (int gi = 0; gi < 4; ++gi) { const int g = 4 + gi, kb = g >> 1, st = g & 1; const s16x8 xs = pack_step(S[kb], st);
        o[0] = MX_MFMA(xs, cat8(qf[1][gi][0], qf[1][gi][1]), o[0]); o[1] = MX_MFMA(xs, cat8(qf[1][gi][2], qf[1][gi][3]), o[1]); }
    MX_SB();
}
template <bool FWD>
__device__ __forceinline__ void intra_vfrags(LAS unsigned char* buf, s16x4 (&vf)[3][2][2], int w, int lane) {
    LAS unsigned char* vimg = buf + 2 * IMG;
    const unsigned h = lane >> 5, blk = (lane >> 4) & 1, q4 = (lane & 15) >> 2, p = lane & 3;
#pragma unroll
    for (int tile = 0; tile < 3; ++tile) { const int st = tile_st<FWD>(tile);
#pragma unroll
        for (int sp = 0; sp < 2; ++sp) { const unsigned R0 = 32 * st + 16 * sp + 4 * h + q4, chv = 4 * w + 2 * blk + (p >> 1);
            vf[tile][sp][0] = tr4(vimg + off_b(R0, chv) + 8 * (p & 1)); vf[tile][sp][1] = tr4(vimg + off_b(R0 + 8, chv) + 8 * (p & 1)); } }
}
template <bool FWD>
__device__ __forceinline__ void chunk_out_intra(LAS unsigned char* pt, f32x16 (&o)[2], const s16x4 (&vf)[3][2][2], int lane) {
    s16x8 pf[3][2];
#pragma unroll
    for (int tile = 0; tile < 3; ++tile) { pf[tile][0] = *(LAS s16x8*)(pt + tile * 2048 + lane * 16); pf[tile][1] = *(LAS s16x8*)(pt + tile * 2048 + 1024 + lane * 16); }
    MX_SB();
#pragma unroll
    for (int tile = 0; tile < 3; ++tile) { const int tt = tile_tt<FWD>(tile);
#pragma unroll
        for (int sp = 0; sp < 2; ++sp) o[tt] = MX_MFMA(cat8(vf[tile][sp][0], vf[tile][sp][1]), pf[tile][sp], o[tt]); }
    MX_SB();
}
__device__ __forceinline__ s16x8 scale8(const s16x8 v, const f32x4 w0, const f32x4 w1) {
    const v4u d = __builtin_bit_cast(v4u, v); v4u o;
    o.x = cvt2(__builtin_bit_cast(float, d.x << 16) * w0.x, __builtin_bit_cast(float, d.x & 0xffff0000u) * w0.y); o.y = cvt2(__builtin_bit_cast(float, d.y << 16) * w0.z, __builtin_bit_cast(float, d.y & 0xffff0000u) * w0.w);
    o.z = cvt2(__builtin_bit_cast(float, d.z << 16) * w1.x, __builtin_bit_cast(float, d.z & 0xffff0000u) * w1.y); o.w = cvt2(__builtin_bit_cast(float, d.w << 16) * w1.z, __builtin_bit_cast(float, d.w & 0xffff0000u) * w1.w);
    return __builtin_bit_cast(s16x8, o); }
template <bool PRE>
__device__ __forceinline__ void chunk_state(LAS unsigned char* kimg, LAS unsigned char* vimg, const LAS float* dvec, const LAS float* wtab, bool cdec, float gam64, f32x16 (&S)[4], int w, int lane, const s16x4 (&fs0)[5][2]) {
    const unsigned h = lane >> 5, blk = (lane >> 4) & 1, q4 = (lane & 15) >> 2, p = lane & 3;
    s16x4 fs[2][5][2];
#define MX_LOADS(bf, KS) do { const unsigned R0 = 16 * (KS) + 8 * h + q4, chv = 4 * w + 2 * blk + (p >> 1); \
        fs[bf][0][0] = tr4(vimg + off_b(R0, chv) + 8 * (p & 1)); fs[bf][0][1] = tr4(vimg + off_b(R0 + 4, chv) + 8 * (p & 1)); \
        _Pragma("unroll") for (int kb = 0; kb < 4; ++kb) { const unsigned chk = 4 * kb + 2 * blk + (p >> 1); \
            fs[bf][1 + kb][0] = tr4(kimg + off_b(R0, chk) + 8 * (p & 1)); fs[bf][1 + kb][1] = tr4(kimg + off_b(R0 + 4, chk) + 8 * (p & 1)); } } while (0)
    if (PRE) {
#pragma unroll
        for (int a_ = 0; a_ < 5; ++a_) { fs[0][a_][0] = fs0[a_][0]; fs[0][a_][1] = fs0[a_][1]; }
    } else { MX_LOADS(0, 0); }
    MX_SB();
    if (cdec) {
#pragma unroll
        for (int kb = 0; kb < 4; ++kb)
#pragma unroll
            for (int i = 0; i < 16; ++i) S[kb][i] *= gam64;
    }
    f32x4 dvA[8];
#pragma unroll
    for (int ks = 0; ks < 4; ++ks) {
        if (ks < 3) { if ((ks & 1) == 0) MX_LOADS(1, ks + 1); else MX_LOADS(0, ks + 1); }
        f32x4 w0, w1; if (cdec) { w0 = *(const LAS f32x4*)(wtab + 32 * h + 8 * ks); w1 = *(const LAS f32x4*)(wtab + 32 * h + 8 * ks + 4); }
        if (!cdec && ks == 3) {
#pragma unroll
            for (int q = 0; q < 8; ++q) dvA[q] = *(const LAS f32x4*)(dvec + 32 * (q >> 2) + 8 * (q & 3) + 4 * h); }
        MX_SB();
        s16x8 bfrag = cat8(fs[ks & 1][0][0], fs[ks & 1][0][1]);
        if (cdec) bfrag = scale8(bfrag, w0, w1);
#pragma unroll
        for (int kb = 0; kb < 4; ++kb) S[kb] = MX_MFMA(cat8(fs[ks & 1][1 + kb][0], fs[ks & 1][1 + kb][1]), bfrag, S[kb]);
        MX_SB();
    }
#undef MX_LOADS
    if (!cdec) {
        f32x4 dvB[8];
#pragma unroll
        for (int q = 0; q < 8; ++q) dvB[q] = *(const LAS f32x4*)(dvec + 32 * (2 + (q >> 2)) + 8 * (q & 3) + 4 * h);
#pragma unroll
        for (int q = 0; q < 8; ++q) { const int kb = q >> 2, g = q & 3; S[kb][4 * g + 0] *= dvA[q].x; S[kb][4 * g + 1] *= dvA[q].y; S[kb][4 * g + 2] *= dvA[q].z; S[kb][4 * g + 3] *= dvA[q].w; }
#pragma unroll
        for (int q = 0; q < 8; ++q) { const int kb = 2 + (q >> 2), g = q & 3; S[kb][4 * g + 0] *= dvB[q].x; S[kb][4 * g + 1] *= dvB[q].y; S[kb][4 * g + 2] *= dvB[q].z; S[kb][4 * g + 3] *= dvB[q].w; }
    }
}

__device__ __forceinline__ size_t chunk_row0(int s, int b, int dir) { return s < 4 ? (size_t)M + (size_t)b * CL + 64 * (dir == 0 ? s : 3 - s) : (size_t)b * L + 64 * (dir == 0 ? s - 4 : 31 - (s - 4)); }
__device__ __forceinline__ void stage_img(LAS unsigned char* dst, const bf16* base, size_t row0, int col0, int iw, int lane) {
    asm volatile("" : "+v"(lane));
    for (int qi = 0; qi < 4; ++qi) { const int i = iw * 4 + qi; const unsigned rl = 4 * i + (lane >> 4), pos = lane & 15, ch = pos ^ (((rl & 3u) << 2) | ((rl >> 2) & 3u));
        __builtin_amdgcn_global_load_lds((const unsigned*)(base + (row0 + rl) * (size_t)D + col0 + 8 * ch), (LAS unsigned*)(dst + i * 1024), 16, 0, MX_NT); }
}
__device__ __forceinline__ void stage_all(LAS unsigned char* lds, LAS float* dv0, const bf16* q, const bf16* k, const bf16* v, int sn, size_t rn, int col0, bool isret, const float* darr, int hh, int wave, int lane) {
    stage_chunk(lds + (sn & 1) * BUFB, q, k, v, rn, col0, sn >= 4 ? 3 : 2, wave - 4, lane);
    if (wave == 4 && !isret) __builtin_amdgcn_global_load_lds((const unsigned*)(darr + (rn >> 6) * 512 + hh * 128 + 4 * lane), (LAS unsigned*)(dv0 + (sn & 1) * 256), 16, 0, MX_NT);
}
__device__ __forceinline__ v4u pair32(const v2u a, const v2u b) { const v2u r0 = __builtin_amdgcn_permlane32_swap(a.x, b.x, false, false), r1 = __builtin_amdgcn_permlane32_swap(a.y, b.y, false, false); return (v4u){r0.x, r1.x, r0.y, r1.y}; }
__device__ __forceinline__ void st16_async(const void* p, v4u v) { asm volatile("global_store_dwordx4 %0, %1, off\n\ts_nop 1" :: "v"(p), "v"(v) : "memory"); }
__device__ __forceinline__ void st8_async(const void* p, v2u v) { asm volatile("global_store_dwordx2 %0, %1, off\n\ts_nop 1" :: "v"(p), "v"(v) : "memory"); }
struct MixIO { const bf16 *qf, *kf, *qb, *kb, *v; const bf16* gmix; bf16* mixout; size_t mixmask; const float *df, *db; bf16* ex; };

struct MixCtx { volatile LAS unsigned* misc; LAS unsigned char* lds; LAS float* ssqx; LAS float* dv0; const bf16* qarr; const bf16* karr; const float* darr; const LAS float* gnl; float gam64, lg; int b, dir, hh, col0, wave, lane; bool isret, cw; };
template <bool FWD>
__device__ __forceinline__ void io_ptile(const MixCtx& c, int s) {
    int lane = c.lane; asm volatile("" : "+v"(lane));
    if (c.wave < 7) ptile<FWD>(c.lds + (s & 1) * BUFB, c.lds + PT_OFF, c.wave - 4, lane, c.isret, c.lg);
    LDS_WAIT(); __builtin_amdgcn_s_barrier(); asm volatile("" ::: "memory");
}
template <bool FWD, int MODE>
__device__ __forceinline__ void io_step(const MixIO& io, const MixCtx& c, int s) {
    const size_t r0 = chunk_row0(s, c.b, c.dir);
    VM_WAIT();
    __builtin_amdgcn_s_barrier(); asm volatile("" ::: "memory");
    if (MODE == 2) { stage_img(c.lds + EXI_OFF, io.ex, r0, c.col0, c.wave - 4, c.lane); stage_img(c.lds + GTI_OFF, io.gmix, r0, c.col0, c.wave - 4, c.lane); }
    if (s + 1 < 36) stage_all(c.lds, c.dv0, c.qarr, c.karr, io.v, s + 1, chunk_row0(s + 1, c.b, c.dir), c.col0, c.isret, c.darr, c.hh, c.wave, c.lane);
    if (MODE >= 1) { io_ptile<FWD>(c, s); }
    if (MODE == 2) {
        const int nfly = (s + 1 < 36) ? ((c.wave == 4 && !c.isret) ? 13 : 12) : 0;
        if (nfly == 13) asm volatile("s_waitcnt vmcnt(13)" ::: "memory"); else if (nfly == 12) asm volatile("s_waitcnt vmcnt(12)" ::: "memory"); else VM_WAIT();
        __builtin_amdgcn_s_barrier(); asm volatile("" ::: "memory");
        __builtin_amdgcn_s_barrier(); asm volatile("" ::: "memory");
    }
}
template <bool FWD, int MODE>
__device__ __forceinline__ void compute_step(const MixIO& io, const MixCtx& c, f32x16 (&S)[4], int s) {
    const size_t r0 = chunk_row0(s, c.b, c.dir);
    LAS unsigned char* eximg = c.lds + EXI_OFF; LAS unsigned char* gtimg = c.lds + GTI_OFF;
    LDS_WAIT(); __builtin_amdgcn_s_barrier(); asm volatile("" ::: "memory");
    int lane = c.lane; asm volatile("" : "+v"(lane));
    LAS unsigned char* buf = c.lds + (s & 1) * BUFB; const int w = c.wave; const LAS float* dvec = c.dv0 + (s & 1) * 256;
    s16x4 fs0[5][2];
    if (MODE == 0) { chunk_state<false>(c.lds + 2 * s * IMG, c.lds + (2 * s + 1) * IMG, c.dv0 + (CTXDV_OFF - DVEC_OFF) / 4 + s * 256, c.dv0, c.isret, c.gam64, S, w, lane, fs0); return; }
    f32x16 o[2];
    chunk_out_inter(buf, S, o, lane, fs0, w);
    if (c.isret) {
        const int r_ = lane & 31; const float f0 = __expf(c.lg * (float)(FWD ? r_ + 1 : 64 - r_)), f1 = __expf(c.lg * (float)(FWD ? r_ + 33 : 32 - r_));
#pragma unroll
        for (int i = 0; i < 16; ++i) { o[0][i] *= f0; o[1][i] *= f1; }
    }
    chunk_state<true>(buf + IMG, buf + 2 * IMG, dvec, c.dv0, c.isret, c.gam64, S, w, lane, fs0);
    s16x4 vf[3][2][2]; intra_vfrags<FWD>(buf, vf, w, lane);
    LDS_WAIT(); __builtin_amdgcn_s_barrier(); asm volatile("" ::: "memory");
    asm volatile("" : "+v"(lane));
    chunk_out_intra<FWD>(c.lds + PT_OFF, o, vf, lane);
    const unsigned r = lane & 31, h = lane >> 5; const int col0 = c.col0;
    if (MODE == 1) {
#pragma unroll
        for (int tt = 0; tt < 2; ++tt)
#pragma unroll
            for (int g = 0; g < 4; g += 2) { v2u wa, wb; wa.x = cvt2(o[tt][4 * g], o[tt][4 * g + 1]); wa.y = cvt2(o[tt][4 * g + 2], o[tt][4 * g + 3]); wb.x = cvt2(o[tt][4 * g + 4], o[tt][4 * g + 5]); wb.y = cvt2(o[tt][4 * g + 6], o[tt][4 * g + 7]);
                st16_async(io.ex + (r0 + 32 * tt + r) * D + col0 + 32 * w + 8 * (g + h), pair32(wa, wb)); }
    } else {
        LDS_WAIT(); __builtin_amdgcn_s_barrier(); asm volatile("" ::: "memory");
        asm volatile("" : "+v"(lane));
        v2u gt[2][4];
#pragma unroll
        for (int tt = 0; tt < 2; ++tt) { float ssq = 0.f;
#pragma unroll
            for (int g = 0; g < 4; ++g) { const unsigned a = off_b(32 * tt + (lane & 31), 4 * w + g) + 8 * (lane >> 5); const v2u oth = *(const LAS v2u*)(eximg + a); gt[tt][g] = *(const LAS v2u*)(gtimg + a);
                float y0 = o[tt][4 * g] + bf2f(oth.x & 0xffff), y1 = o[tt][4 * g + 1] + bf2f(oth.x >> 16), y2 = o[tt][4 * g + 2] + bf2f(oth.y & 0xffff), y3 = o[tt][4 * g + 3] + bf2f(oth.y >> 16);
                if (!c.isret) { y0 *= bf2f(gt[tt][g].x & 0xffff); y1 *= bf2f(gt[tt][g].x >> 16); y2 *= bf2f(gt[tt][g].y & 0xffff); y3 *= bf2f(gt[tt][g].y >> 16); }
                o[tt][4 * g] = y0; o[tt][4 * g + 1] = y1; o[tt][4 * g + 2] = y2; o[tt][4 * g + 3] = y3; ssq += (y0 * y0 + y1 * y1) + (y2 * y2 + y3 * y3); }
            ssq = xsum32(ssq);
            if (h == 0) c.ssqx[w * 64 + 32 * tt + r] = ssq; }
        LDS_WAIT(); __builtin_amdgcn_s_barrier(); asm volatile("" ::: "memory");
#pragma unroll
        for (int tt = 0; tt < 2; ++tt) { const int t = 32 * tt + r; const float tot = (c.ssqx[t] + c.ssqx[64 + t]) + (c.ssqx[128 + t] + c.ssqx[192 + t]); const float rstd = rsqrtf(tot * (1.f / 128.f) + EPS);
            v2u wv[4];
#pragma unroll
            for (int g = 0; g < 4; ++g) { const f32x4 gn = *(const LAS f32x4*)(c.gnl + 32 * w + 8 * g + 4 * h);
                float y0 = o[tt][4 * g] * rstd * gn.x, y1 = o[tt][4 * g + 1] * rstd * gn.y, y2 = o[tt][4 * g + 2] * rstd * gn.z, y3 = o[tt][4 * g + 3] * rstd * gn.w;
                if (c.isret) { y0 *= bf2f(gt[tt][g].x & 0xffff); y1 *= bf2f(gt[tt][g].x >> 16); y2 *= bf2f(gt[tt][g].y & 0xffff); y3 *= bf2f(gt[tt][g].y >> 16); }
                wv[g].x = cvt2(y0, y1); wv[g].y = cvt2(y2, y3); }
#pragma unroll
            for (int g = 0; g < 4; g += 2) st16_async(io.mixout + (((r0 + t) * D + col0 + 32 * w + 8 * (g + h)) & io.mixmask), pair32(wv[g], wv[g + 1])); }
    }
}
template <bool FWD>
__device__ __forceinline__ void mixer_run(const MixIO& io, const MixCtx& c, const XcdBarrier& gbar) {
#define MSTAMP(i) do { if (EXP_TA >= 0 && ((i) == EXP_TA || (i) == EXP_TB) && blockIdx.x == 0 && threadIdx.x == 0) c.misc[16 + ((i) == EXP_TB ? 1 : 0)] = (unsigned)__builtin_amdgcn_s_memrealtime(); } while (0)
    if (c.cw) {
        f32x16 S[4];
#pragma unroll
        for (int kb = 0; kb < 4; ++kb)
#pragma unroll
            for (int i = 0; i < 16; ++i) S[kb][i] = 0.f;
        MSTAMP(40);
        for (int s = 0; s < 4; ++s) compute_step<FWD, 0>(io, c, S, s);
        MSTAMP(41);
        for (int s = 4; s < 20; ++s) compute_step<FWD, 1>(io, c, S, s);
        MSTAMP(42);
        xcd_barrier(gbar);
        MSTAMP(43);
        for (int s = 20; s < 36; ++s) compute_step<FWD, 2>(io, c, S, s);
        MSTAMP(44);
    } else {
        const bool dvw = (c.wave == 4 && !c.isret);
        for (int s = 0; s < 4; ++s) { const size_t rn = chunk_row0(s, c.b, c.dir);
            stage_chunk(c.lds + 2 * s * IMG, c.qarr, c.karr, io.v, rn, c.col0, 2, c.wave - 4, c.lane);
            if (dvw) __builtin_amdgcn_global_load_lds((const unsigned*)(c.darr + (rn >> 6) * 512 + c.hh * 128 + 4 * c.lane), (LAS unsigned*)(c.dv0 + (CTXDV_OFF - DVEC_OFF) / 4 + s * 256), 16, 0, MX_NT); }
#define MX_CW(a, b) do { if (dvw) asm volatile("s_waitcnt vmcnt(" #b ")" ::: "memory"); else asm volatile("s_waitcnt vmcnt(" #a ")" ::: "memory"); __builtin_amdgcn_s_barrier(); asm volatile("" ::: "memory"); } while (0)
        MX_CW(24, 27);
        MX_CW(16, 18);
        MX_CW(8, 9);
        stage_all(c.lds, c.dv0, c.qarr, c.karr, io.v, 4, chunk_row0(4, c.b, c.dir), c.col0, c.isret, c.darr, c.hh, c.wave, c.lane);
        MX_CW(12, 13);
        stage_all(c.lds, c.dv0, c.qarr, c.karr, io.v, 5, chunk_row0(5, c.b, c.dir), c.col0, c.isret, c.darr, c.hh, c.wave, c.lane);
        MX_CW(12, 13);
#undef MX_CW
        io_ptile<FWD>(c, 4);
        for (int s = 5; s < 20; ++s) io_step<FWD, 1>(io, c, s);
        xcd_barrier(gbar);
        for (int s = 20; s < 36; ++s) io_step<FWD, 2>(io, c, s);
    }
}
__device__ __forceinline__ void mixer_phase(Frame& F, const MixIO& io, const XcdBarrier& gbar) {
    const int scan = F.vcu; MixCtx c;
    c.dir = scan & 1; const int head = (scan >> 1) & 7; c.b = scan >> 4; c.isret = head >= 4; c.hh = head & 3; c.col0 = head * 128;
    c.misc = F.MISC; c.lds = F.lds; c.ssqx = (LAS float*)(F.lds + SSQ_OFF); c.dv0 = (LAS float*)(F.lds + DVEC_OFF);
    c.qarr = (c.dir == 0 || c.isret) ? io.qf : io.qb;    c.karr = (c.dir == 0 || c.isret) ? io.kf : io.kb; c.darr = c.dir == 0 ? io.df : io.db;
    c.lg = c.isret ? -log1pf(expf(-F.ret_decay[c.dir * 4 + c.hh])) : 0.f; c.gam64 = c.isret ? expf(64.f * c.lg) : 0.f;
    if (c.isret && F.tid < 64) { const int h_ = F.tid >> 5, ks_ = (F.tid >> 3) & 3, j_ = F.tid & 7, sr = 16 * ks_ + 8 * h_ + j_; c.dv0[F.tid] = __expf(c.lg * (float)(c.dir == 0 ? 63 - sr : sr)); }
    { LAS float* gl = (LAS float*)(F.lds + GN_OFF); if (F.tid < 128) gl[F.tid] = ((c.isret ? F.ret_norm_g : F.hgrn_norm_g) + c.hh * 128)[F.tid]; c.gnl = gl; }
    c.wave = F.wave; c.lane = F.lane; c.cw = F.wave < 4;
    if (c.dir == 0) mixer_run<true>(io, c, gbar); else mixer_run<false>(io, c, gbar);
}
}


struct Args { const float* in[19]; float* out; unsigned char* ws; int ph_lo, ph_hi, li, pad; };
__global__ void __launch_bounds__(NWAVES * 64, 2) mk_fwd(Args args) {
    extern __shared__ __attribute__((aligned(16))) unsigned char lds[];
    Frame F;
    F.lds = (LAS unsigned char*)lds;
    F.MISC = (volatile LAS unsigned*)(F.lds + MISC_OFF);
    F.tid = threadIdx.x; F.lane = F.tid & 63; F.wave = __builtin_amdgcn_readfirstlane(F.tid >> 6);
    F.G = gridDim.x; { const int bx = blockIdx.x; F.vcu = (F.G % 8 == 0) ? (bx % 8) * (F.G / 8) + bx / 8 : bx; }
    F.ws = args.ws; F.ctl = (gu32*)(args.ws + WS_CTL);
    F.x = args.in[0]; F.c = args.in[1]; F.ctx = args.in[2]; F.c_ctx = args.in[3]; F.w_mod = args.in[4]; F.b_mod = args.in[5]; F.norm1_g = args.in[6]; F.w_in = args.in[7];
    F.hgrn_lb = args.in[8]; F.hgrn_norm_g = args.in[9]; F.ret_decay = args.in[10]; F.ret_norm_g = args.in[11]; F.w_out = args.in[12]; F.norm2_g = args.in[13]; F.w_up = args.in[14];
    F.conv_w = args.in[15]; F.conv_b = args.in[16]; F.w_down = args.in[17]; F.final_g = args.in[18]; F.out = args.out;
    for (int u = F.tid; u < (LDS_BYTES - LDSCTL_OFF) / 4; u += NWAVES * 64) ((LAS unsigned*)(F.lds + LDSCTL_OFF))[u] = 0u;
    __syncthreads();
    XcdBarrier bar = xcd_barrier_post((unsigned*)(F.ctl + CW_BAR) + args.li * XCD_BAR_WORDS, F.MISC + 8);
    const int lo = args.ph_lo, hi = args.ph_hi;
#define IN(k) (lo <= (k) && (k) < hi)
#define BOTH(k) (IN(k) && IN((k) + 1))
    const float* MOD = (const float*)(F.ws + WS_MOD);

    STAMP(0);
    REFRESH_IDS();
    if (IN(0)) { p0_prologue(F); }
    STAMP(1);
    REFRESH_IDS();
    if (IN(1)) { p0b_phase(F, (bf16*)F.out); if (BOTH(1)) xcd_barrier(bar); }
    STAMP(2);
    REFRESH_IDS();
    if (IN(2)) {
        pg8::Gemm g{(const pg8::bf16_t*)F.out, (const pg8::bf16_t*)(F.ws + WS_WIN), MT, NIN, D}; InOrder S; S.init(F.G, (int)blockIdx.x);
        EpiIn E{F.ws, F.lds + RING_BYTES, F.hgrn_lb, F.ret_decay};
        pg8::gemm_phase<EpiIn, InOrder, true, true>(F.lds + RING_OFF, g, S, E, F.wave);
        late_transposes(F);
        if (BOTH(2)) xcd_barrier(bar);
    }
    STAMP(3);
    REFRESH_IDS();
    if (IN(3)) {
        mx::MixIO io{(const bf16*)(F.ws + WS_QF), (const bf16*)(F.ws + WS_KF), (const bf16*)(F.ws + WS_QB), (const bf16*)(F.ws + WS_KB), (const bf16*)(F.ws + WS_V), (bf16*)(F.ws + WS_G),
                     (bf16*)(F.ws + WS_G), ~(size_t)0, (const float*)(F.ws + WS_DF), (const float*)(F.ws + WS_DB), (bf16*)F.out};
        bias2_phase(F);
        mx::mixer_phase(F, io, bar);
        if (IN(5)) xcd_barrier(bar);
    }
    STAMP(5);
    REFRESH_IDS();
    if (IN(5)) {
        pg8::Gemm g{(const pg8::bf16_t*)(F.ws + WS_MIXED), (const pg8::bf16_t*)(F.ws + WS_WOUT), M, D, D}; pg8::StaticOrder S; S.init(M, D, F.G, (int)blockIdx.x);
        EpiOut E{F.x, (bf16*)(F.ws + WS_X1B), (bf16*)(F.ws + WS_A2), MOD, F.norm2_g, (float*)(F.ws + WS_SSQ1)};
        pg8::gemm_phase<EpiOut, pg8::StaticOrder, true, true>(F.lds + RING_OFF, g, S, E, F.wave);
        if (BOTH(5)) xcd_barrier(bar);
    }
    STAMP(6);
    REFRESH_IDS();
    if (IN(6)) {
        pg8::Gemm g{(const pg8::bf16_t*)(F.ws + WS_A2), (const pg8::bf16_t*)(F.ws + WS_WUP), M, DUP, D}; pg8::StaticOrder S; S.init(M, DUP, F.G, (int)blockIdx.x);
        EpiUp E{(const float*)(F.ws + WS_SSQ1), (const float*)(F.ws + WS_BIAS2), F.conv_w, F.conv_b, (bf16*)(F.ws + WS_HID), (bf16*)(F.ws + WS_EDGEG)};
        pg8::gemm_phase<EpiUp, pg8::StaticOrder, true, true>(F.lds + RING_OFF, g, S, E, F.wave);
        if (BOTH(6)) xcd_barrier(bar);
    }
    STAMP(7);
    REFRESH_IDS();
    if (IN(7)) { edge_phase(F); if (BOTH(7)) xcd_barrier(bar); }
    STAMP(8);
    REFRESH_IDS();
    if (IN(8)) {
        pg8::Gemm g{(const pg8::bf16_t*)(F.ws + WS_HID), (const pg8::bf16_t*)(F.ws + WS_WDN), M, D, DFF}; pg8::StaticOrder S; S.init(M, D, F.G, (int)blockIdx.x);
        EpiDownNorm E{(const bf16*)(F.ws + WS_X1B), F.out, MOD, F.final_g, (float*)(F.ws + WS_XBUF), (unsigned*)(F.ctl + CW_PANEL), F.lds + RING_BYTES};
        pg8::gemm_phase<EpiDownNorm, pg8::StaticOrder, true, true>(F.lds + RING_OFF, g, S, E, F.wave);
    }
    STAMP(9);
    STAMP(10);
    if (EXP_TA >= 0 && blockIdx.x == 0 && threadIdx.x == 0) { const unsigned dt = (F.MISC[17] - F.MISC[16]) * (unsigned)EXP_AMP; const unsigned long long t0 = __builtin_amdgcn_s_memrealtime();
        while ((unsigned)(__builtin_amdgcn_s_memrealtime() - t0) < dt) __builtin_amdgcn_s_sleep(8); }
#undef IN
#undef BOTH
}


static int mk_grid() {
    static int grid = 0;
    if (grid == 0) {
        int dev = 0, cus = 0, per_cu = 0;
        if (hipGetDevice(&dev) != hipSuccess || hipDeviceGetAttribute(&cus, hipDeviceAttributeMultiprocessorCount, dev) != hipSuccess) { fprintf(stderr, "kernel_launch: device query failed\n"); grid = -1; return grid; }
        if (hipFuncSetAttribute((const void*)mk_fwd, hipFuncAttributeMaxDynamicSharedMemorySize, LDS_BYTES) != hipSuccess) { fprintf(stderr, "kernel_launch: hipFuncSetAttribute failed\n"); grid = -1; return grid; }
        if (hipOccupancyMaxActiveBlocksPerMultiprocessor(&per_cu, (const void*)mk_fwd, NWAVES * 64, LDS_BYTES) != hipSuccess || per_cu < 1) { fprintf(stderr, "kernel_launch: occupancy query reports %d blocks per CU\n", per_cu); (void)hipGetLastError(); grid = -1; return grid; }
        grid = cus;
    }
    return grid;
}
static void mk_launch(const Args& a0, int lo, int hi, int li, int grid, hipStream_t stream) {
    Args a = a0; a.ph_lo = lo; a.ph_hi = hi; a.li = li; a.pad = 0;
    hipLaunchKernelGGL(mk_fwd, dim3(grid), dim3(NWAVES * 64), LDS_BYTES, stream, a);
}
extern "C" void kernel_launch(void* const* d_in, const int* in_sizes, int n_in, void* d_out, int out_size, void* d_ws, size_t ws_size, hipStream_t stream) {
    const int grid = mk_grid(); if (grid < 0) return;
    if (n_in != 19 || out_size != M * D || ws_size < WS_END) { fprintf(stderr, "kernel_launch: unexpected shapes\n"); return; }
    (void)hipMemsetAsync((char*)d_ws + WS_CTL, 0, CTL_ZERO_BYTES, stream);
    Args a{}; for (int i = 0; i < 19; ++i) a.in[i] = (const float*)d_in[i]; a.out = (float*)d_out; a.ws = (unsigned char*)d_ws;
    mk_launch(a, 0, 10, 0, grid, stream);
}
```
